# Optimizing an MI355X kernel written in HIP

```python
import jax, jax.numpy as jnp
from jax import lax
import numpy as np

D_MODEL = 1024
BATCH = 4
SEQ = 4096
DEPTH = 2

N_MIXERS = 2
N_ATTN_LAYERS = (DEPTH + 1) // 2
N_HGRN_LAYERS = DEPTH // 2
DILATED_GROUPS = ((128, 1), (512, 4), (2048, 16))
N_GROUPS = len(DILATED_GROUPS)
ATTN_HEADS = 8
ATTN_HEAD_DIM = D_MODEL // ATTN_HEADS
ATTN_WIDTH = ATTN_HEADS * ATTN_HEAD_DIM
NUM_BUCKETS = 32
MAX_DISTANCE = 2048
HGRN_HEADS = 8
HGRN_KDIM = 128
HGRN_VDIM = D_MODEL // HGRN_HEADS
HGRN_FWD = HGRN_HEADS * HGRN_KDIM
HGRN_CHUNK = 64
FFN_HIDDEN = ((8 * D_MODEL // 3 + 255) // 256) * 256
RMS_EPS = 1e-6

kernel_name = "hybrid_dilated_attn_hgrn2_swiglu_adaln"


def rms_norm(x, gain, eps=RMS_EPS):
    xf = x.astype(jnp.float32)
    y = xf * lax.rsqrt(jnp.mean(xf * xf, axis=-1, keepdims=True) + eps)
    return (y * gain.astype(jnp.float32)).astype(x.dtype)


def t5_bucket(dist):
    n = np.asarray(dist, dtype=np.int64)
    max_exact = NUM_BUCKETS // 2
    large = max_exact + (np.log(np.maximum(n, 1) / max_exact)
                         / np.log(MAX_DISTANCE / max_exact)
                         * (NUM_BUCKETS - max_exact)).astype(np.int64)
    large = np.minimum(large, NUM_BUCKETS - 1)
    return np.where(n < max_exact, n, large).astype(np.int32)


def dilated_window_group(q, k, v, bias_j, window, dilation):
    B, S, H, Dh = q.shape
    d = dilation
    blk = window // dilation
    span = d * blk
    s_pad = -(-S // span) * span
    pad = s_pad - S
    if pad:
        padw = ((0, 0), (0, pad), (0, 0), (0, 0))
        q, k, v = jnp.pad(q, padw), jnp.pad(k, padw), jnp.pad(v, padw)
    L = s_pad // d
    nb = L // blk

    def to_sub(t):
        X = t.shape[-1]
        return t.reshape(B, L, d, H, X).transpose(0, 2, 1, 3, 4).reshape(B, d, nb, blk, H, X)

    def from_sub(t):
        X = t.shape[-1]
        return t.reshape(B, d, L, H, X).transpose(0, 2, 1, 3, 4).reshape(B, s_pad, H, X)[:, :S]

    qb, kb, vb = to_sub(q), to_sub(k), to_sub(v)
    def with_prev(t):
        prev = jnp.concatenate([jnp.zeros_like(t[:, :, :1]), t[:, :, :-1]], axis=2)
        return jnp.concatenate([prev, t], axis=3)
    kk, vv = with_prev(kb), with_prev(vb)

    qi = np.arange(blk)[:, None]
    ki = np.arange(2 * blk)[None, :]
    j = blk + qi - ki
    band = (j >= 0) & (j <= blk)
    mask = np.broadcast_to(band, (nb, blk, 2 * blk)).copy()
    mask[0, :, :blk] = False
    mask = jnp.asarray(mask.reshape(1, 1, nb, blk, 1, 2 * blk))
    bias = bias_j[np.clip(j, 0, blk)].transpose(0, 2, 1)

    s = jnp.einsum('brnqhd,brnkhd->brnqhk', qb, kk) * (Dh ** -0.5) + bias
    s = jnp.where(mask, s, -jnp.inf)
    m = jnp.max(s, axis=-1, keepdims=True)
    p = jnp.exp(s - m)
    l = jnp.sum(p, axis=-1, keepdims=True)
    o = jnp.einsum('brnqhk,brnkhd->brnqhd', p, vv) / l
    return from_sub(o), from_sub(m), from_sub(l)


def dilated_attention(h, w_qkv, w_out, q_gain, k_gain, rel_bias):
    B, S, _ = h.shape
    qkv = (h @ w_qkv).astype(jnp.float32).reshape(B, S, N_GROUPS, 3, ATTN_HEADS, ATTN_HEAD_DIM)
    outs, maxes, dens = [], [], []
    for g, (window, dil) in enumerate(DILATED_GROUPS):
        q = rms_norm(qkv[:, :, g, 0], q_gain[g])
        k = rms_norm(qkv[:, :, g, 1], k_gain[g])
        v = qkv[:, :, g, 2]
        steps = window // dil
        bucket = t5_bucket(np.arange(steps + 1) * dil)
        bias_j = rel_bias[bucket, g * ATTN_HEADS:(g + 1) * ATTN_HEADS].astype(jnp.float32)
        o, m, l = dilated_window_group(q, k, v, bias_j, window, dil)
        outs.append(o); maxes.append(m); dens.append(l)
    o = jnp.stack(outs)
    m = jnp.stack(maxes)
    l = jnp.stack(dens)
    wts = l * jnp.exp(m - jnp.max(m, axis=0, keepdims=True))
    out = jnp.sum(wts * o, axis=0) / jnp.sum(wts, axis=0)
    return out.reshape(B, S, ATTN_WIDTH).astype(h.dtype) @ w_out


def hgrn2_mixer(h, w_in, w_out, gnorm_gain, lower_bound):
    B, S, _ = h.shape
    proj = h @ w_in
    q, f, i, g = jnp.split(proj, [HGRN_FWD, 2 * HGRN_FWD, 2 * HGRN_FWD + D_MODEL], axis=-1)
    q = jax.nn.silu(q.astype(jnp.float32))
    lb = lower_bound.astype(jnp.float32)
    fg = lb + (1.0 - lb) * jax.nn.sigmoid(f.astype(jnp.float32))
    logf = jnp.log(fg)
    kin = 1.0 - fg
    nc = S // HGRN_CHUNK

    def chunk(t, dim):
        t = t.reshape(B, S, HGRN_HEADS, dim).transpose(0, 2, 1, 3)
        return jnp.moveaxis(t.reshape(B, HGRN_HEADS, nc, HGRN_CHUNK, dim), 2, 0)

    qc, kc, gc = chunk(q, HGRN_KDIM), chunk(kin, HGRN_KDIM), chunk(logf, HGRN_KDIM)
    vc = chunk(i.astype(jnp.float32), HGRN_VDIM)
    tri = jnp.asarray(np.tril(np.ones((HGRN_CHUNK, HGRN_CHUNK), dtype=bool))[None, None, :, :, None])

    def step(state, xs):
        qq, kq, vq, gq = xs
        G = jnp.cumsum(gq, axis=2)
        diff = G[:, :, :, None, :] - G[:, :, None, :, :]
        decay = jnp.exp(jnp.where(tri, diff, -jnp.inf))
        A = jnp.einsum('bhtk,bhsk,bhtsk->bhts', qq, kq, decay)
        o = jnp.einsum('bhts,bhsv->bhtv', A, vq) + jnp.einsum('bhtk,bhkv->bhtv', qq * jnp.exp(G), state)
        G_last = G[:, :, -1:, :]
        new_state = (jnp.exp(G_last[:, :, 0, :])[..., None] * state
                     + jnp.einsum('bhsk,bhsv->bhkv', kq * jnp.exp(G_last - G), vq))
        return new_state, o

    state0 = jnp.zeros((B, HGRN_HEADS, HGRN_KDIM, HGRN_VDIM), jnp.float32)
    _, o = lax.scan(step, state0, (qc, kc, vc, gc))
    o = jnp.moveaxis(o, 0, 2).reshape(B, HGRN_HEADS, S, HGRN_VDIM).transpose(0, 2, 1, 3)
    o = rms_norm(o, gnorm_gain).reshape(B, S, D_MODEL)
    o = o * jax.nn.silu(g.astype(jnp.float32))
    return o.astype(h.dtype) @ w_out


def swiglu(h, w1, w3, w2):
    return (jax.nn.silu(h @ w1) * (h @ w3)) @ w2


def setup_inputs(seed: int = 0) -> dict:
    key = jax.random.key(seed)
    ks = jax.random.split(key, 20)
    f32 = jnp.float32
    def nrm(k, shape, fan_in, mult=1.0):
        return jax.random.normal(k, shape, f32) * (mult * fan_in ** -0.5)
    def gain(k, shape):
        return 1.0 + 0.05 * jax.random.normal(k, shape, f32)
    return {
        "x": jax.random.normal(ks[0], (BATCH, SEQ, D_MODEL), f32),
        "c": jax.random.normal(ks[1], (BATCH, D_MODEL), f32),
        "rel_bias": 0.5 * jax.random.normal(ks[2], (NUM_BUCKETS, N_GROUPS * ATTN_HEADS), f32),
        "ada_w": nrm(ks[3], (DEPTH, D_MODEL, 6 * D_MODEL), D_MODEL, 0.5),
        "ada_b": 0.02 * jax.random.normal(ks[4], (DEPTH, 6 * D_MODEL), f32),
        "norm_mix": gain(ks[5], (DEPTH, D_MODEL)),
        "norm_ffn": gain(ks[6], (DEPTH, D_MODEL)),
        "attn_w_qkv": nrm(ks[7], (N_ATTN_LAYERS, D_MODEL, N_GROUPS * 3 * ATTN_WIDTH), D_MODEL),
        "attn_w_out": nrm(ks[8], (N_ATTN_LAYERS, ATTN_WIDTH, D_MODEL), ATTN_WIDTH),
        "attn_q_gain": gain(ks[9], (N_ATTN_LAYERS, N_GROUPS, ATTN_HEAD_DIM)),
        "attn_k_gain": gain(ks[10], (N_ATTN_LAYERS, N_GROUPS, ATTN_HEAD_DIM)),
        "hgrn_w_in": nrm(ks[11], (N_HGRN_LAYERS, D_MODEL, 2 * HGRN_FWD + 2 * D_MODEL), D_MODEL),
        "hgrn_w_out": nrm(ks[12], (N_HGRN_LAYERS, D_MODEL, D_MODEL), D_MODEL),
        "hgrn_gnorm": gain(ks[13], (N_HGRN_LAYERS, HGRN_VDIM)),
        "hgrn_lower_bounds": jax.random.normal(ks[14], (DEPTH, HGRN_FWD), f32),
        "ffn_w1": nrm(ks[15], (DEPTH, D_MODEL, FFN_HIDDEN), D_MODEL),
        "ffn_w3": nrm(ks[16], (DEPTH, D_MODEL, FFN_HIDDEN), D_MODEL),
        "ffn_w2": nrm(ks[17], (DEPTH, FFN_HIDDEN, D_MODEL), FFN_HIDDEN),
    }


def reference(x, c, rel_bias, ada_w, ada_b, norm_mix, norm_ffn, attn_w_qkv, attn_w_out,
              attn_q_gain, attn_k_gain, hgrn_w_in, hgrn_w_out, hgrn_gnorm, hgrn_lower_bounds,
              ffn_w1, ffn_w3, ffn_w2):
    p = jax.nn.softmax(hgrn_lower_bounds.astype(jnp.float32), axis=0)
    lbs = jnp.cumsum(p, axis=0) - p[0]
    c_act = jax.nn.silu(c)
    for i in range(DEPTH):
        mod = c_act @ ada_w[i] + ada_b[i]
        sh1, sc1, g1, sh2, sc2, g2 = jnp.split(mod[:, None, :], 6, axis=-1)
        h = rms_norm(x, norm_mix[i]) * (1.0 + sc1) + sh1
        a = i // N_MIXERS
        if i % N_MIXERS == 0:
            y = dilated_attention(h, attn_w_qkv[a], attn_w_out[a], attn_q_gain[a],
                                  attn_k_gain[a], rel_bias)
        else:
            y = hgrn2_mixer(h, hgrn_w_in[a], hgrn_w_out[a], hgrn_gnorm[a], lbs[i])
        x = x + g1 * y
        h = rms_norm(x, norm_ffn[i]) * (1.0 + sc2) + sh2
        x = x + g2 * swiglu(h, ffn_w1[i], ffn_w3[i], ffn_w2[i])
    return x
```

```cpp
#include <hip/hip_runtime.h>
#include <cstdio>
#include <cstdint>
#include <cmath>
namespace pg8 {
#define PG8_LAS __attribute__((address_space(3)))
typedef unsigned short bf16_t;
typedef short bf16x8 __attribute__((ext_vector_type(8)));
typedef float f32x4 __attribute__((ext_vector_type(4)));
typedef unsigned u32x4 __attribute__((ext_vector_type(4)));
constexpr int BM = 256, BK = 64, HALF = 128, HTB = HALF * BK * 2  , STAGE_BYTES = 8 * HTB, NXCD = 8, WGM = 8;

__host__ __device__ __forceinline__ int lds_byte(int r, int c) { const int st = (r >> 4) * 2 + (c >> 5), rr = r & 15, cc = c & 31, ob = rr * 64 + cc * 2; return st * 1024 + (ob ^ (((ob >> 9) & 1) << 5)); }
__host__ __device__ __forceinline__ void stage_rc(int b, int& R, int& C) { const int st = b / 1024, sb = b % 1024, swz = sb ^ (((sb >> 9) & 1) << 5); R = (st >> 1) * 16 + swz / 64; C = (st & 1) * 32 + (swz % 64) / 2; }
__host__ __device__ __forceinline__ int perm32(int rho) { const int n = rho >> 4, i = rho & 15; return 8 * (i >> 2) + 4 * n + (i & 3); }

struct Unit { int pm, pn; };
struct Gemm { const bf16_t* A; const bf16_t* Bt; int M, N, K; };

struct StaticOrder {
    int nM, nN, nwg, G, c;
    __host__ __device__ void init(int M, int N, int G_, int c_) { nM = M / BM; nN = N / BM; nwg = nM * nN; G = G_; c = c_; }
    __host__ __device__ bool next(int i, Unit& u) const {
        const long L = (long)i * G + c; if (L >= nwg) return false;
        int wgid = (int)L; { const int q = nwg / NXCD, r = nwg % NXCD, xcd = wgid % NXCD, off = wgid / NXCD; wgid = (xcd < r ? xcd * (q + 1) : r * (q + 1) + (xcd - r) * q) + off; }
        const int nig = WGM * nN, gid = wgid / nig, fm = gid * WGM, gsz = (nM - fm) < WGM ? (nM - fm) : WGM;
        u.pm = fm + ((wgid % nig) % gsz); u.pn = (wgid % nig) / gsz; return true;
    }
    __device__ __forceinline__ void a_ready(const Unit&) const {}
    __device__ __forceinline__ void done(const Unit&) const {}
};


__device__ __forceinline__ unsigned cvt_pk_bf16(float lo, float hi) { unsigned r; asm volatile("v_cvt_pk_bf16_f32 %0, %1, %2" : "=v"(r) : "v"(lo), "v"(hi)); return r; }
__device__ __forceinline__ float silu_f(float a) { return a * __builtin_amdgcn_rcpf(1.0f + __expf(-a)); }
__device__ __forceinline__ float sigmoid_f(float a) { return __builtin_amdgcn_rcpf(1.0f + __expf(-a)); }
__device__ __forceinline__ u32x4 pack8(const f32x4 a, const f32x4 b) { u32x4 w; w.x = cvt_pk_bf16(a[0], a[1]); w.y = cvt_pk_bf16(a[2], a[3]); w.z = cvt_pk_bf16(b[0], b[1]); w.w = cvt_pk_bf16(b[2], b[3]); return w; }

struct EpiQKV {
    static constexpr bool PERM = true, AFTER_DRAIN = false;
    bf16_t* base; int dl;
    __device__ __forceinline__ void operator()(const f32x4 (&acc)[2][2][4][2], const Unit& u, int wr, int wc, int fr, int fq) const {
        const int which = u.pn >> 2, h0 = (u.pn & 3) * 2, dcol = wc * 32 + 8 * fq;
        bf16_t* ob = base + (size_t)which * (size_t)(4 * 8 * 4096 * 128);
        const int row0 = u.pm * BM + wr * 64 + fr;
#pragma unroll
        for (int ai = 0; ai < 2; ++ai)
#pragma unroll
            for (int m = 0; m < 4; ++m) { const int row = row0 + ai * HALF + m * 16, b = row >> 12, t = row & 4095;
                const int sp = ((t & ((1 << dl) - 1)) << (12 - dl)) + (t >> dl);
#pragma unroll
                for (int bj = 0; bj < 2; ++bj) { bf16_t* p = ob + ((size_t)((b * 8 + h0 + bj) * 4096 + sp)) * 128 + dcol;
                    *(u32x4*)p = pack8(acc[ai][bj][m][0], acc[ai][bj][m][1]); } }
    }
};
struct EpiRes {
    static constexpr bool PERM = false, AFTER_DRAIN = false;
    const float* base; float* out; const float* gate;
    __device__ __forceinline__ void operator()(const f32x4 (&acc)[2][2][4][2], const Unit& u, int wr, int wc, int fr, int fq) const {
        const int row0 = u.pm * BM + wr * 64 + fr, col0 = u.pn * BM + wc * 32 + 4 * fq, b = (u.pm * BM) >> 12;
        f32x4 gv[2][2];
#pragma unroll
        for (int bj = 0; bj < 2; ++bj)
#pragma unroll
            for (int n = 0; n < 2; ++n) gv[bj][n] = *(const f32x4*)(gate + b * 6144 + col0 + bj * HALF + n * 16);
#pragma unroll
        for (int ai = 0; ai < 2; ++ai)
#pragma unroll
            for (int m = 0; m < 4; ++m) { const size_t off = (size_t)(row0 + ai * HALF + m * 16) * 1024 + col0;
#pragma unroll
                for (int bj = 0; bj < 2; ++bj)
#pragma unroll
                    for (int n = 0; n < 2; ++n) { const f32x4 bs = *(const f32x4*)(base + off + bj * HALF + n * 16);
                        *(f32x4*)(out + off + bj * HALF + n * 16) = bs + gv[bj][n] * acc[ai][bj][m][n]; } }
    }
};
struct EpiSwiGLU {
    static constexpr bool PERM = true, AFTER_DRAIN = false;
    bf16_t* H; int ldh;
    __device__ __forceinline__ void operator()(const f32x4 (&acc)[2][2][4][2], const Unit& u, int wr, int wc, int fr, int fq) const {
        const int row0 = u.pm * BM + wr * 64 + fr, col0 = u.pn * HALF + wc * 32 + 8 * fq;
#pragma unroll
        for (int ai = 0; ai < 2; ++ai)
#pragma unroll
            for (int m = 0; m < 4; ++m) { f32x4 r0, r1;
#pragma unroll
                for (int i = 0; i < 4; ++i) { r0[i] = silu_f(acc[ai][0][m][0][i]) * acc[ai][1][m][0][i]; r1[i] = silu_f(acc[ai][0][m][1][i]) * acc[ai][1][m][1][i]; }
                *(u32x4*)(H + (size_t)(row0 + ai * HALF + m * 16) * ldh + col0) = pack8(r0, r1); }
    }
};
struct EpiHgrnNaive {
    static constexpr bool PERM = true, AFTER_DRAIN = false;
    bf16_t* QS; float* FG; bf16_t* V; bf16_t* SG; const float* lbs;
    __device__ __forceinline__ void operator()(const f32x4 (&acc)[2][2][4][2], const Unit& u, int wr, int wc, int fr, int fq) const {
        typedef unsigned u32x2 __attribute__((ext_vector_type(2)));
        const int head = u.pn >> 1, type = u.pn & 1, col0 = head * 128 + wc * 32 + 8 * fq, row0 = u.pm * BM + wr * 64 + fr;
#pragma unroll
        for (int n = 0; n < 2; ++n) {
            const f32x4 lb = *(const f32x4*)(lbs + col0 + 4 * n);
#pragma unroll
            for (int ai = 0; ai < 2; ++ai)
#pragma unroll
                for (int m = 0; m < 4; ++m) { const size_t off = (size_t)(row0 + ai * HALF + m * 16) * 1024 + col0 + 4 * n; f32x4 a, b;
                    if (type == 0) {
#pragma unroll
                        for (int i = 0; i < 4; ++i) { a[i] = silu_f(acc[ai][0][m][n][i]); b[i] = lb[i] + (1.0f - lb[i]) * sigmoid_f(acc[ai][1][m][n][i]); }
                        u32x2 w; w.x = cvt_pk_bf16(a[0], a[1]); w.y = cvt_pk_bf16(a[2], a[3]); *(u32x2*)(QS + off) = w; *(f32x4*)(FG + off) = b;
                    } else {
#pragma unroll
                        for (int i = 0; i < 4; ++i) { a[i] = acc[ai][0][m][n][i]; b[i] = silu_f(acc[ai][1][m][n][i]); }
                        u32x2 w; w.x = cvt_pk_bf16(a[0], a[1]); w.y = cvt_pk_bf16(a[2], a[3]); *(u32x2*)(V + off) = w;
                        u32x2 x; x.x = cvt_pk_bf16(b[0], b[1]); x.y = cvt_pk_bf16(b[2], b[3]); *(u32x2*)(SG + off) = x;
                    }
                    asm volatile("" ::: "memory"); }
        }
    }
};

template <class Epi, class Sched, bool ALIGN_EPI = false, bool SP2 = false>
__device__ __forceinline__ void gemm_phase(PG8_LAS unsigned char* lds, const Gemm g, const Sched& S, const Epi& E) {
    const int tid = threadIdx.x, wid = __builtin_amdgcn_readfirstlane(tid >> 6), lane = tid & 63, wr = wid >> 2, wc = wid & 3, fr = lane & 15, fq = lane >> 4;
    const int K = g.K, nt = K / BK;
    unsigned voffA[2], voffB[2];
#pragma unroll
    for (int i = 0; i < 2; ++i) { int R, C; stage_rc(tid * 16 + i * 8192, R, C); const int Rb = Epi::PERM ? ((R & ~31) + perm32(R & 31)) : R;
        voffA[i] = (unsigned)(R * K + C) * 2u; voffB[i] = (unsigned)(Rb * K + C) * 2u; }
    const size_t kstep = (size_t)(BK * 2);
    const size_t hstep = (size_t)HALF * K * 2;
    const size_t tstep = 2 * hstep;
    const unsigned ldsw = (unsigned)wid * 1024u;
    const int aoff = lds_byte(wr * 64 + fr, fq * 8), boff = lds_byte(wc * 32 + fr, fq * 8);
#define PG8_SA(b, h) (((b) * 2 + (h)) * HTB)
#define PG8_SB(b, h) ((4 + (b) * 2 + (h)) * HTB)
#define PG8_STAGE(bufoff, gbase, voff) do { _Pragma("unroll") for (int _i = 0; _i < 2; ++_i) \
        __builtin_amdgcn_global_load_lds((const unsigned*)((const char*)(gbase) + (voff)[_i]), (PG8_LAS unsigned*)(lds + (bufoff) + ldsw + _i * 8192), 16, 0, 0); } while (0)
#define PG8_LDA(dst, b, h) do { _Pragma("unroll") for (int m = 0; m < 4; ++m) _Pragma("unroll") for (int k = 0; k < 2; ++k) dst[m][k] = *(const PG8_LAS bf16x8*)(lds + PG8_SA(b, h) + aoff + m * 2048 + k * 1024); } while (0)
#define PG8_LDB(dst, b, h) do { _Pragma("unroll") for (int n = 0; n < 2; ++n) _Pragma("unroll") for (int k = 0; k < 2; ++k) dst[n][k] = *(const PG8_LAS bf16x8*)(lds + PG8_SB(b, h) + boff + n * 2048 + k * 1024); } while (0)
#define PG8_MMA(ai, bj, At, Bt) do { __builtin_amdgcn_s_setprio(1); _Pragma("unroll") for (int m = 0; m < 4; ++m) _Pragma("unroll") for (int n = 0; n < 2; ++n) _Pragma("unroll") for (int k = 0; k < 2; ++k) \
        acc[ai][bj][m][n] = __builtin_amdgcn_mfma_f32_16x16x32_bf16(Bt[n][k], At[m][k], acc[ai][bj][m][n], 0, 0, 0); __builtin_amdgcn_s_setprio(0); } while (0)
#define PG8_WAIT_V(n) asm volatile("s_waitcnt vmcnt(" #n ")" ::: "memory")
#define PG8_WAIT_L(n) asm volatile("s_waitcnt lgkmcnt(" #n ")" ::: "memory")
#define PG8_BAR __builtin_amdgcn_s_barrier()
#define PG8_SCHED __builtin_amdgcn_sched_barrier(0)
    Unit cur, nxt; int ui = 0;
    if (!S.next(0, cur)) return;
    f32x4 acc[2][2][4][2];
#pragma unroll
    for (int a = 0; a < 2; ++a)
#pragma unroll
        for (int b = 0; b < 2; ++b)
#pragma unroll
            for (int m = 0; m < 4; ++m)
#pragma unroll
                for (int n = 0; n < 2; ++n) acc[a][b][m][n] = (f32x4){0.f, 0.f, 0.f, 0.f};
    bf16x8 At[4][2], B0[2][2], B1[2][2];
    const char* cA = (const char*)g.A + (size_t)cur.pm * tstep; const char* cB = (const char*)g.Bt + (size_t)cur.pn * tstep;
    S.a_ready(cur);
    if constexpr (SP2) {
        PG8_STAGE(PG8_SB(0, 0), cB, voffB); PG8_STAGE(PG8_SB(0, 1), cB + hstep, voffB); PG8_STAGE(PG8_SA(0, 0), cA, voffA); PG8_STAGE(PG8_SA(0, 1), cA + hstep, voffA);
        if (wr == 1) PG8_BAR;
        PG8_WAIT_V(2); PG8_BAR;
        PG8_STAGE(PG8_SB(1, 0), cB + kstep, voffB); PG8_STAGE(PG8_SA(1, 0), cA + kstep, voffA); PG8_STAGE(PG8_SB(1, 1), cB + hstep + kstep, voffB);
        PG8_WAIT_V(6); PG8_BAR;
    } else {
        PG8_STAGE(PG8_SB(0, 0), cB, voffB); PG8_STAGE(PG8_SA(0, 0), cA, voffA); PG8_STAGE(PG8_SB(0, 1), cB + hstep, voffB); PG8_STAGE(PG8_SA(0, 1), cA + hstep, voffA);
        if (wr == 1) PG8_BAR;
        PG8_WAIT_V(4); PG8_BAR;
        PG8_STAGE(PG8_SB(1, 0), cB + kstep, voffB); PG8_STAGE(PG8_SA(1, 0), cA + kstep, voffA); PG8_STAGE(PG8_SB(1, 1), cB + hstep + kstep, voffB);
        PG8_WAIT_V(6); PG8_BAR;
    }
    for (;;) {
        const bool has_next = S.next(ui + 1, nxt);
        const char* nA = has_next ? (const char*)g.A + (size_t)nxt.pm * tstep : cA; const char* nB = has_next ? (const char*)g.Bt + (size_t)nxt.pn * tstep : cB;
        for (int t = 0; t < nt; t += 2) {
            const bool last = (t == nt - 2);
            const char* a1 = cA + (size_t)(t + 1) * kstep;
            const char* a2 = last ? nA : cA + (size_t)(t + 2) * kstep; const char* b2 = last ? nB : cB + (size_t)(t + 2) * kstep;
            const char* a3 = a2 + kstep; const char* b3 = b2 + kstep;
            if (last && has_next) S.a_ready(nxt);
            if constexpr (SP2) {
            PG8_LDB(B0, 0, 0); PG8_LDB(B1, 0, 1); PG8_SCHED; PG8_LDA(At, 0, 0); PG8_STAGE(PG8_SA(1, 1), a1 + hstep, voffA);
            PG8_WAIT_V(8); PG8_WAIT_L(0); PG8_BAR; PG8_MMA(0, 0, At, B0); PG8_MMA(0, 1, At, B1); PG8_BAR; PG8_SCHED;
            PG8_LDA(At, 0, 1); PG8_STAGE(PG8_SB(0, 0), b2, voffB); PG8_STAGE(PG8_SB(0, 1), b2 + hstep, voffB); PG8_STAGE(PG8_SA(0, 0), a2, voffA);
            PG8_WAIT_V(8); PG8_WAIT_L(0); PG8_BAR; PG8_MMA(1, 0, At, B0); PG8_MMA(1, 1, At, B1); PG8_BAR; PG8_SCHED;
            PG8_LDB(B0, 1, 0); PG8_LDB(B1, 1, 1); PG8_SCHED; PG8_LDA(At, 1, 0); PG8_STAGE(PG8_SA(0, 1), a2 + hstep, voffA);
            PG8_WAIT_V(8); PG8_WAIT_L(0); PG8_BAR; PG8_MMA(0, 0, At, B0); PG8_MMA(0, 1, At, B1); PG8_BAR; PG8_SCHED;
            PG8_LDA(At, 1, 1); PG8_STAGE(PG8_SB(1, 0), b3, voffB); PG8_STAGE(PG8_SB(1, 1), b3 + hstep, voffB); PG8_STAGE(PG8_SA(1, 0), a3, voffA);
            PG8_WAIT_V(8); PG8_WAIT_L(0); PG8_BAR; PG8_MMA(1, 0, At, B0); PG8_MMA(1, 1, At, B1); PG8_BAR; PG8_SCHED;
            } else {
            PG8_LDB(B0, 0, 0); PG8_SCHED; PG8_LDA(At, 0, 0); PG8_STAGE(PG8_SA(1, 1), a1 + hstep, voffA);
            PG8_WAIT_L(8); PG8_BAR; PG8_WAIT_L(0); PG8_MMA(0, 0, At, B0); PG8_BAR; PG8_SCHED;
            PG8_LDB(B1, 0, 1); PG8_STAGE(PG8_SB(0, 0), b2, voffB);
            PG8_BAR; PG8_WAIT_L(0); PG8_MMA(0, 1, At, B1); PG8_BAR;
            PG8_LDA(At, 0, 1); PG8_STAGE(PG8_SA(0, 0), a2, voffA);
            PG8_BAR; PG8_WAIT_L(0); PG8_MMA(1, 0, At, B0); PG8_BAR; PG8_SCHED;
            PG8_STAGE(PG8_SB(0, 1), b2 + hstep, voffB);
            PG8_WAIT_V(6); PG8_BAR; PG8_MMA(1, 1, At, B1); PG8_BAR;
            PG8_LDB(B0, 1, 0); PG8_SCHED; PG8_LDA(At, 1, 0); PG8_STAGE(PG8_SA(0, 1), a2 + hstep, voffA);
            PG8_WAIT_L(8); PG8_BAR; PG8_WAIT_L(0); PG8_MMA(0, 0, At, B0); PG8_BAR; PG8_SCHED;
            PG8_LDB(B1, 1, 1); PG8_STAGE(PG8_SB(1, 0), b3, voffB);
            PG8_BAR; PG8_WAIT_L(0); PG8_MMA(0, 1, At, B1); PG8_BAR;
            PG8_LDA(At, 1, 1); PG8_STAGE(PG8_SA(1, 0), a3, voffA);
            PG8_BAR; PG8_WAIT_L(0); PG8_MMA(1, 0, At, B0); PG8_BAR; PG8_SCHED;
            PG8_STAGE(PG8_SB(1, 1), b3 + hstep, voffB);
            PG8_WAIT_V(6); PG8_BAR; PG8_MMA(1, 1, At, B1); PG8_BAR;
            }
        }
        if constexpr (ALIGN_EPI) { if (wr == 0) PG8_BAR; }
        if constexpr (!Epi::AFTER_DRAIN) { E(acc, cur, wr, wc, fr, fq); S.done(cur); }
        if (!has_next) break;
#pragma unroll
        for (int a = 0; a < 2; ++a)
#pragma unroll
            for (int b = 0; b < 2; ++b)
#pragma unroll
                for (int m = 0; m < 4; ++m)
#pragma unroll
                    for (int n = 0; n < 2; ++n) acc[a][b][m][n] = (f32x4){0.f, 0.f, 0.f, 0.f};
        cur = nxt; cA = nA; cB = nB; ++ui;
        if constexpr (ALIGN_EPI) { if (wr == 1) PG8_BAR; }
    }
    PG8_WAIT_V(0);
    if constexpr (!ALIGN_EPI) { if (wr == 0) PG8_BAR; }
    PG8_BAR;
    if constexpr (Epi::AFTER_DRAIN) { E.fused(acc, cur, wr, wc, fr, fq, lds, wid, lane); S.done(cur); }
#undef PG8_SA
#undef PG8_SB
#undef PG8_STAGE
#undef PG8_LDA
#undef PG8_LDB
#undef PG8_MMA
#undef PG8_WAIT_V
#undef PG8_WAIT_L
#undef PG8_BAR
#undef PG8_SCHED
}
}
#define GAS __attribute__((address_space(1)))
#define LAS __attribute__((address_space(3)))
typedef unsigned short bf16;
typedef unsigned v4u __attribute__((ext_vector_type(4)));
typedef float f32x4 __attribute__((ext_vector_type(4)));
typedef short bf16x8 __attribute__((ext_vector_type(8)));
typedef GAS unsigned gu32;
typedef GAS unsigned long long gu64;
#define RLX_AGENT __ATOMIC_RELAXED, __HIP_MEMORY_SCOPE_AGENT
#define LDS_WAIT() asm volatile("s_waitcnt lgkmcnt(0)" ::: "memory")
#define VM_WAIT() asm volatile("s_waitcnt vmcnt(0)" ::: "memory")
__device__ __forceinline__ unsigned long long rt() { return __builtin_amdgcn_s_memrealtime(); }
__device__ __forceinline__ unsigned f2bf(float f) { unsigned u = __builtin_bit_cast(unsigned, f); return (u + 0x7fffu + ((u >> 16) & 1u)) >> 16; }
__device__ __forceinline__ unsigned pk2(float lo, float hi) { return f2bf(lo) | (f2bf(hi) << 16); }

#define XB_TMO      128
#define XB_XCNT(j)  (256  + 64 * (j))
#define XB_XSUB(j)  (1280 + 64 * (j))
#define XB_XGEN(j)  (2304 + 64 * (j))
#define XB_TOP      3328
#define XB_TOPGEN   3392
#define XCD_BAR_WORDS 3456
#define XB_SPIN_CAP (1u << 18)

__device__ __forceinline__ unsigned xb_ld(unsigned* p)              { return __hip_atomic_load(p, __ATOMIC_RELAXED, __HIP_MEMORY_SCOPE_AGENT); }
__device__ __forceinline__ unsigned xb_add(unsigned* p, unsigned v) { return __hip_atomic_fetch_add(p, v, __ATOMIC_RELAXED, __HIP_MEMORY_SCOPE_AGENT); }
__device__ __forceinline__ unsigned xb_xcc_id() { return (unsigned)__builtin_amdgcn_s_getreg((3 << 11) | 20) & 0xFu; }
#define XB_SPIN(cond, bar) do { unsigned _sp = 0; while (cond) { __builtin_amdgcn_s_sleep(1); \
    if ((++_sp & 255u) == 0u) { if (xb_ld(&(bar)[XB_TMO])) break; if (_sp > XB_SPIN_CAP) { atomicAdd(&(bar)[XB_TMO], 1u); break; } } } } while (0)

struct XcdBarrier {
    unsigned* bar; unsigned x;
    volatile LAS unsigned* st;
};

__device__ __forceinline__ XcdBarrier xcd_barrier_post(unsigned* bar, volatile LAS unsigned* st) {
    XcdBarrier b; b.bar = bar; b.x = xb_xcc_id(); b.st = st;
    if (threadIdx.x == 0) (void)xb_add(&bar[XB_XCNT(b.x)], 1u);
    return b;
}
__device__ __forceinline__ void xcd_barrier_complete(unsigned* bar, unsigned x, unsigned& nloc, unsigned& nx) {
    const unsigned G = gridDim.x * gridDim.y * gridDim.z;
    unsigned sum, cnt, mine, sp = 0u;
    for (;;) {
        sum = 0u; cnt = 0u; mine = 0u;
#pragma unroll
        for (unsigned j = 0; j < 16; ++j) { const unsigned c = xb_ld(&bar[XB_XCNT(j)]); sum += c; cnt += (c > 0u) ? 1u : 0u; mine = (j == x) ? c : mine; }
        if (sum == G) break;
        __builtin_amdgcn_s_sleep(1);
        if ((++sp & 255u) == 0u) { if (xb_ld(&bar[XB_TMO])) break; if (sp > XB_SPIN_CAP) { atomicAdd(&bar[XB_TMO], 1u); break; } }
    }
    nloc = mine > 0u ? mine : 1u; nx = cnt > 0u ? cnt : 1u;
}

__device__ __forceinline__ void xcd_barrier(const XcdBarrier& b) {
    asm volatile("s_waitcnt vmcnt(0)" ::: "memory");
    __syncthreads();
    if (threadIdx.x == 0) {
        unsigned* bar = b.bar;
        __builtin_amdgcn_s_waitcnt(0);
        unsigned nloc = b.st[0], nx = b.st[1];
        if (nloc == 0u) { xcd_barrier_complete(bar, b.x, nloc, nx); b.st[0] = nloc; b.st[1] = nx; }
        const unsigned old = xb_add(&bar[XB_XSUB(b.x)], 1u);
        const unsigned gen = old / nloc;
        if (old + 1u == (gen + 1u) * nloc) {
            __builtin_amdgcn_fence(__ATOMIC_RELEASE, "agent");
            asm volatile("s_waitcnt vmcnt(0)" ::: "memory");
            const unsigned og = xb_add(&bar[XB_TOP], 1u);
            const unsigned tg = og / nx;
            if (og + 1u == (tg + 1u) * nx) xb_add(&bar[XB_TOPGEN], 1u);
            else XB_SPIN(xb_ld(&bar[XB_TOPGEN]) == tg, bar);
            __builtin_amdgcn_fence(__ATOMIC_ACQUIRE, "agent");
            xb_add(&bar[XB_XGEN(b.x)], 1u);
            asm volatile("s_waitcnt vmcnt(0)" ::: "memory");
        } else {
            XB_SPIN(xb_ld(&bar[XB_XGEN(b.x)]) == gen, bar);
            __builtin_amdgcn_fence(__ATOMIC_ACQUIRE, "agent");
            asm volatile("s_waitcnt vmcnt(0)" ::: "memory");
        }
    }
    __syncthreads();
}

constexpr int NWAVES = 8;
constexpr int NB = 4, SEQ = 4096, D = 1024, M = NB * SEQ, NH = 8, HD = 128, NG = 3, FF = 2816, NUP = 2 * FF;
constexpr float RMS_EPS = 1e-6f, ATT_SCALE = 0.08838834764831845f;
constexpr size_t MiB = 1u << 20;
constexpr size_t WS_CTL = 0, CTL_ZERO_BYTES = 1 * MiB;
constexpr size_t WS_MOD = 1 * MiB;
constexpr size_t WS_LBS = 1 * MiB + 256 * 1024;
constexpr size_t WS_LUT = 1 * MiB + 320 * 1024;
constexpr size_t WS_ML = 2 * MiB;
constexpr size_t WS_WQKV = 8 * MiB, WS_WO = 26 * MiB, WS_W13_0 = 28 * MiB, WS_W2_0 = 39 * MiB;
constexpr size_t WS_WIN = 44 * MiB + 512 * 1024, WS_WHO = WS_WIN + 8 * MiB, WS_W13_1 = WS_WHO + 2 * MiB, WS_W2_1 = WS_W13_1 + 11 * MiB;
constexpr size_t WS_SG = 8 * MiB;
constexpr size_t WS_ACT = 72 * MiB;
constexpr size_t WS_BIG = 104 * MiB;
constexpr size_t WS_R2 = 200 * MiB;
constexpr size_t WS_END = 256 * MiB;
constexpr size_t QKV_STRIDE = (size_t)NB * NH * SEQ * HD;
constexpr int LUT_N = 129;
constexpr int CW_BAR = 4096;
constexpr int RING_BYTES = 131072, LDSCTL_OFF = RING_BYTES, MISC_OFF = LDSCTL_OFF + 320, LDS_BYTES = 147456;

struct Args { const float* in[18]; float* out; unsigned char* ws; int ph_lo, ph_hi; };
struct Frame {
    LAS unsigned char* lds; volatile LAS unsigned* MISC; gu32* ctl;
    int tid, lane, wave, vcu, G;
};

typedef const __attribute__((address_space(4))) Args* kargs_t;
__device__ __forceinline__ kargs_t kargs() { kargs_t p = (kargs_t)__builtin_amdgcn_kernarg_segment_ptr(); asm volatile("" : "+s"(p)); return p; }
__device__ __forceinline__ float bf2f(unsigned short h) { return __builtin_bit_cast(float, (unsigned)h << 16); }
__device__ __forceinline__ float bflo(unsigned w) { return __builtin_bit_cast(float, w << 16); }
__device__ __forceinline__ float bfhi(unsigned w) { return __builtin_bit_cast(float, w & 0xffff0000u); }
__device__ __forceinline__ float wave_sum(float v) {
#pragma unroll
    for (int o = 1; o < 64; o <<= 1) v += __shfl_xor(v, o);
    return v;
}
__device__ __forceinline__ void tr_item(const float* W, int Nsrc, int K, bf16* WT, int k0, int n0s, int drow0, LAS float* scr, int lane) {
#pragma unroll 8
    for (int i = 0; i < 32; ++i) { const int kk = 2 * i + (lane >> 5); scr[kk * 33 + (lane & 31)] = W[(size_t)(k0 + kk) * Nsrc + n0s + (lane & 31)]; }
    LDS_WAIT(); asm volatile("" ::: "memory");
    const int c = lane & 7;
#pragma unroll
    for (int j = 0; j < 4; ++j) { const int n = (lane >> 3) + 8 * j; const LAS float* s = scr + (8 * c) * 33 + n;
        v4u o; o.x = pk2(s[0 * 33], s[1 * 33]); o.y = pk2(s[2 * 33], s[3 * 33]); o.z = pk2(s[4 * 33], s[5 * 33]); o.w = pk2(s[6 * 33], s[7 * 33]);
        *(GAS v4u*)(WT + (size_t)(drow0 + n) * K + k0 + 8 * c) = o; }
    LDS_WAIT(); asm volatile("" ::: "memory");
}
__device__ __forceinline__ int t5_bucket(int n) {
    if (n < 16) return n;
    int v = 16 + (int)(log((double)n / 16.0) / log(128.0) * 16.0);
    return v > 31 ? 31 : v;
}
__device__ __forceinline__ void p0_prologue(Frame& F) {
    const kargs_t A = kargs(); unsigned char* const ws = A->ws;
    if (F.vcu < 48) {
        LAS float* cact = (LAS float*)F.lds;
        LAS float* red = (LAS float*)(F.lds + 16384);
        for (int i = F.tid; i < 4096; i += NWAVES * 64) { const float c = A->in[1][i]; cact[i] = c * __builtin_amdgcn_rcpf(1.0f + __expf(-c)); }
        __syncthreads();
        const int l = F.vcu / 24, cg = F.vcu % 24;
        const float* wp = A->in[3] + (size_t)l * 1024 * 6144 + (size_t)(F.wave * 128) * 6144 + cg * 256 + F.lane * 4;
        f32x4 a0 = {0.f, 0.f, 0.f, 0.f}, a1 = a0, a2 = a0, a3 = a0;
#pragma unroll 8
        for (int k = 0; k < 128; ++k) { const f32x4 wv = *(const f32x4*)(wp + (size_t)k * 6144); const int kk = F.wave * 128 + k;
            a0 += wv * cact[kk]; a1 += wv * cact[1024 + kk]; a2 += wv * cact[2048 + kk]; a3 += wv * cact[3072 + kk]; }
        LAS f32x4* r4 = (LAS f32x4*)red + F.wave * 256;
        r4[F.lane] = a0; r4[64 + F.lane] = a1; r4[128 + F.lane] = a2; r4[192 + F.lane] = a3;
        __syncthreads();
        float* mod = (float*)(ws + WS_MOD);
        for (int idx = F.tid; idx < 1024; idx += NWAVES * 64) { const int b = idx >> 8, col = idx & 255; float s = 0.f;
#pragma unroll
            for (int w = 0; w < 8; ++w) s += red[(w * 4 + b) * 256 + col];
            mod[(size_t)(l * 4 + b) * 6144 + cg * 256 + col] = s + A->in[4][l * 6144 + cg * 256 + col]; }
        __syncthreads();
    } else if (F.vcu == 48) {
        float* lbs = (float*)(ws + WS_LBS);
        for (int k = F.tid; k < 1024; k += NWAVES * 64) { const float b0 = A->in[14][k], b1 = A->in[14][1024 + k]; lbs[k] = 1.0f / (1.0f + expf(b0 - b1)); }
    } else if (F.vcu == 49) {
        float* lut = (float*)(ws + WS_LUT);
        for (int i = F.tid; i < NG * NH * LUT_N; i += NWAVES * 64) { const int j = i % LUT_N, gh = i / LUT_N, g = gh >> 3;
            lut[i] = A->in[2][t5_bucket(j << (2 * g)) * (NG * NH) + gh]; }
    }
    LAS float* scr = (LAS float*)(F.lds + F.wave * 16384);
    const int gw = F.vcu * NWAVES + F.wave, NGW = F.G * NWAVES;
    constexpr int I_QKV = 16 * 288, I_SQ = 16 * 32, I_UP = 16 * 88, I_DN = 44 * 32, I_IN = 16 * 128;
    constexpr int NITEMS = I_QKV + I_SQ + 2 * I_UP + I_DN + I_IN + I_SQ + 2 * I_UP + I_DN;
    for (int it = gw; it < NITEMS; it += NGW) {
        int r = it;
        if (r < I_QKV) { const int kb = r / 288, nb = r % 288; tr_item(A->in[7], 9216, 1024, (bf16*)(ws + WS_WQKV), 64 * kb, 32 * nb, 32 * nb, scr, F.lane); continue; } r -= I_QKV;
        if (r < I_SQ) { const int kb = r / 32, nb = r % 32; tr_item(A->in[8], 1024, 1024, (bf16*)(ws + WS_WO), 64 * kb, 32 * nb, 32 * nb, scr, F.lane); continue; } r -= I_SQ;
        if (r < I_IN) { const int kb = r / 128, nb = r % 128;
            const int seg = nb >> 5, hh = (nb >> 2) & 7, sub = nb & 3;
            tr_item(A->in[11], 4096, 1024, (bf16*)(ws + WS_WIN), 64 * kb, 32 * nb, 256 * (2 * hh + (seg >> 1)) + 128 * (seg & 1) + 32 * sub, scr, F.lane); continue; } r -= I_IN;
        if (r < I_SQ) { const int kb = r / 32, nb = r % 32; tr_item(A->in[12], 1024, 1024, (bf16*)(ws + WS_WHO), 64 * kb, 32 * nb, 32 * nb, scr, F.lane); continue; } r -= I_SQ;
        const int l = r / (2 * I_UP + I_DN); r -= l * (2 * I_UP + I_DN);
        if (r < 2 * I_UP) { const int which = r / I_UP, rr = r % I_UP, kb = rr / 88, nb = rr % 88;
            tr_item((which ? A->in[16] : A->in[15]) + (size_t)l * 1024 * FF, FF, 1024, (bf16*)(ws + (l ? WS_W13_1 : WS_W13_0)), 64 * kb, 32 * nb, 256 * (nb >> 2) + 128 * which + 32 * (nb & 3), scr, F.lane); continue; } r -= 2 * I_UP;
        { const int kb = r / 32, nb = r % 32; tr_item(A->in[17] + (size_t)l * FF * 1024, 1024, FF, (bf16*)(ws + (l ? WS_W2_1 : WS_W2_0)), 64 * kb, 32 * nb, 32 * nb, scr, F.lane); }
    }
}
__device__ __forceinline__ void norm_mod_pass(Frame& F, const float* x, const float* gain, const float* sh, const float* sc) {
    unsigned char* const ws = kargs()->ws;
    const int gw = F.vcu * NWAVES + F.wave, NGW = F.G * NWAVES;
    bf16* act = (bf16*)(ws + WS_ACT);
    for (int r0 = gw * 8; r0 < M; r0 += NGW * 8) {
        const int b = r0 >> 12;
        f32x4 gam[4], shv[4];
#pragma unroll
        for (int j = 0; j < 4; ++j) { const int c = 4 * F.lane + 256 * j; const f32x4 gn = *(const f32x4*)(gain + c), s = *(const f32x4*)(sc + b * 6144 + c);
            gam[j] = gn * (s + 1.0f); shv[j] = *(const f32x4*)(sh + b * 6144 + c); }
#pragma unroll 1
        for (int rr = 0; rr < 8; rr += 2) {
            f32x4 v[2][4];
#pragma unroll
            for (int q = 0; q < 2; ++q)
#pragma unroll
                for (int j = 0; j < 4; ++j) v[q][j] = *(const GAS f32x4*)(x + (size_t)(r0 + rr + q) * D + 4 * F.lane + 256 * j);
#pragma unroll
            for (int q = 0; q < 2; ++q) { float s = 0.f;
#pragma unroll
                for (int j = 0; j < 4; ++j) s += (v[q][j].x * v[q][j].x + v[q][j].y * v[q][j].y) + (v[q][j].z * v[q][j].z + v[q][j].w * v[q][j].w);
                const float rstd = 1.0f / sqrtf(wave_sum(s) * (1.0f / D) + RMS_EPS);
                GAS unsigned long long* o8 = (GAS unsigned long long*)(act + (size_t)(r0 + rr + q) * D) + F.lane;
#pragma unroll
                for (int j = 0; j < 4; ++j) { const f32x4 o = v[q][j] * rstd * gam[j] + shv[j];
                    o8[64 * j] = (unsigned long long)pk2(o.x, o.y) | ((unsigned long long)pk2(o.z, o.w) << 32); } }
        }
    }
}
__device__ __forceinline__ void attn_naive(Frame& F, int g) {
    const kargs_t A = kargs(); unsigned char* const ws = A->ws; float* const outp = A->out;
    const int dl = 2 * g, dmask = (1 << dl) - 1, Lsub = SEQ >> dl;
    const bf16* Q = (const bf16*)(ws + WS_BIG); const bf16* K = Q + QKV_STRIDE; const bf16* V = K + QKV_STRIDE;
    float* ML = (float*)(ws + WS_ML); float* orun = outp; bf16* act = (bf16*)(ws + WS_ACT);
    const float* lut = (const float*)(ws + WS_LUT);
    const int l2 = 2 * F.lane;
    const float qk0 = A->in[9][g * 128 + l2] * A->in[10][g * 128 + l2], qk1 = A->in[9][g * 128 + l2 + 1] * A->in[10][g * 128 + l2 + 1];
    const int gw = F.vcu * NWAVES + F.wave, NGW = F.G * NWAVES;
    for (int item = gw; item < M * NH; item += NGW) {
        const int row = item >> 3, h = item & 7, b = row >> 12, t = row & 4095, r = t & dmask, mi = t >> dl;
        const size_t hb = ((size_t)(b * 8 + h) * SEQ + (size_t)r * Lsub) * HD;
        const unsigned qw = *(const GAS unsigned*)(Q + hb + (size_t)mi * HD + l2);
        float q0 = bflo(qw), q1 = bfhi(qw);
        const float rq = 1.0f / sqrtf(wave_sum(q0 * q0 + q1 * q1) * (1.0f / HD) + RMS_EPS);
        q0 *= rq * qk0; q1 *= rq * qk1;
        float m = -1e30f, l = 0.f, o0 = 0.f, o1 = 0.f;
        if (g > 0) { m = ML[(size_t)item * 2]; l = ML[(size_t)item * 2 + 1]; o0 = orun[(size_t)row * D + h * HD + l2]; o1 = orun[(size_t)row * D + h * HD + l2 + 1]; }
        const float* bl = lut + (g * 8 + h) * LUT_N;
        const int nj = mi < 128 ? mi : 128;
        for (int j = 0; j <= nj; ++j) {
            const size_t ko = hb + (size_t)(mi - j) * HD + l2;
            const unsigned kw = *(const GAS unsigned*)(K + ko), vw = *(const GAS unsigned*)(V + ko);
            const float k0 = bflo(kw), k1 = bfhi(kw);
            float a = q0 * k0 + q1 * k1, s2 = k0 * k0 + k1 * k1;
#pragma unroll
            for (int o = 1; o < 64; o <<= 1) { a += __shfl_xor(a, o); s2 += __shfl_xor(s2, o); }
            const float s = a * (1.0f / sqrtf(s2 * (1.0f / HD) + RMS_EPS)) * ATT_SCALE + bl[j];
            const float mn = fmaxf(m, s), al = __expf(m - mn), p = __expf(s - mn);
            l = l * al + p; o0 = o0 * al + p * bflo(vw); o1 = o1 * al + p * bfhi(vw); m = mn;
        }
        if (g < 2) { if (F.lane == 0) { ML[(size_t)item * 2] = m; ML[(size_t)item * 2 + 1] = l; }
            orun[(size_t)row * D + h * HD + l2] = o0; orun[(size_t)row * D + h * HD + l2 + 1] = o1; }
        else { const float il = 1.0f / l; *(GAS unsigned*)(act + (size_t)row * D + h * HD + l2) = pk2(o0 * il, o1 * il); }
    }
}
__device__ __forceinline__ void hgrn_naive(Frame& F) {
    if (F.vcu >= NB * NH) return;
    const kargs_t A = kargs(); unsigned char* const ws = A->ws;
    const int b = F.vcu >> 3, h = F.vcu & 7, kq = F.wave >> 1, v = 64 * (F.wave & 1) + F.lane;
    const bf16* QS = (const bf16*)(ws + WS_BIG); const float* FG = (const float*)(ws + WS_BIG + 32 * MiB);
    const bf16* V = (const bf16*)(ws + WS_R2); const bf16* SG = (const bf16*)(ws + WS_SG); bf16* act = (bf16*)(ws + WS_ACT);
    LAS float* po = (LAS float*)F.lds;
    float S[32];
#pragma unroll
    for (int j = 0; j < 32; ++j) S[j] = 0.f;
    const int tt2 = F.tid >> 5, l32 = F.tid & 31;
    const f32x4 gn = *(const f32x4*)(A->in[13] + 4 * l32);
    for (int t0 = 0; t0 < SEQ; t0 += 16) {
        for (int tt = 0; tt < 16; ++tt) {
            const size_t ro = (size_t)(b * SEQ + t0 + tt) * D + h * HD;
            const float iv = bf2f(V[ro + v]);
            const float* fgp = FG + ro + 32 * kq; const bf16* qp = QS + ro + 32 * kq;
            float acc = 0.f;
#pragma unroll
            for (int j4 = 0; j4 < 8; ++j4) { const f32x4 f4 = *(const f32x4*)(fgp + 4 * j4); const unsigned long long q4 = *(const unsigned long long*)(qp + 4 * j4);
#pragma unroll
                for (int i = 0; i < 4; ++i) { const float fg = f4[i], qv = bf2f((unsigned short)(q4 >> (16 * i)));
                    S[4 * j4 + i] = fg * S[4 * j4 + i] + (1.0f - fg) * iv; acc += qv * S[4 * j4 + i]; } }
            po[(tt * 4 + kq) * 128 + v] = acc;
        }
        __syncthreads();
        { const size_t ro = (size_t)(b * SEQ + t0 + tt2) * D + h * HD + 4 * l32;
          const LAS f32x4* p4 = (const LAS f32x4*)po + (tt2 * 4) * 32 + l32;
          const f32x4 o = (p4[0] + p4[32]) + (p4[64] + p4[96]);
          float ss = (o.x * o.x + o.y * o.y) + (o.z * o.z + o.w * o.w);
#pragma unroll
          for (int sft = 1; sft < 32; sft <<= 1) ss += __shfl_xor(ss, sft);
          const float rstd = 1.0f / sqrtf(ss * (1.0f / HD) + RMS_EPS);
          const unsigned long long sg = *(const unsigned long long*)(SG + ro);
          const f32x4 r = o * rstd * gn;
          const unsigned lo = pk2(r.x * bf2f((unsigned short)sg), r.y * bf2f((unsigned short)(sg >> 16))), hi = pk2(r.z * bf2f((unsigned short)(sg >> 32)), r.w * bf2f((unsigned short)(sg >> 48)));
          *(GAS unsigned long long*)(act + ro) = (unsigned long long)lo | ((unsigned long long)hi << 32); }
        __syncthreads();
    }
}

constexpr int NPHASE = 19;
__global__ void __launch_bounds__(NWAVES * 64, 2) mk_fwd(Args args) {
    extern __shared__ __attribute__((aligned(16))) unsigned char lds[];
    Frame F;
    F.lds = (LAS unsigned char*)lds; F.MISC = (volatile LAS unsigned*)(F.lds + MISC_OFF);
    F.tid = threadIdx.x; F.lane = F.tid & 63; F.wave = __builtin_amdgcn_readfirstlane(F.tid >> 6);
    F.G = gridDim.x; { const int bx = blockIdx.x; F.vcu = (F.G % 8 == 0) ? (bx % 8) * (F.G / 8) + bx / 8 : bx; }
    F.ctl = (gu32*)(args.ws + WS_CTL);
    for (int u = F.tid; u < (LDS_BYTES - LDSCTL_OFF) / 4; u += NWAVES * 64) ((LAS unsigned*)(F.lds + LDSCTL_OFF))[u] = 0u;
    __syncthreads();
    const int lo = args.ph_lo, hi = args.ph_hi;
    const bool multi = (hi - lo) > 1;
    XcdBarrier bar; bar.bar = (unsigned*)(F.ctl + CW_BAR); bar.x = 0; bar.st = nullptr;
    if (multi) bar = xcd_barrier_post((unsigned*)(F.ctl + CW_BAR), F.MISC + 8);
#ifndef PH_MASK
#define PH_MASK 0xFFFFFFFFu
#endif
#define IN(k) (((PH_MASK >> (k)) & 1u) && lo <= (k) && (k) < hi)
#define SEAM(k) do { if (IN(k) && IN((k) + 1)) xcd_barrier(bar); } while (0)
#define PHASE_PTRS const kargs_t A = kargs(); unsigned char* const ws = A->ws; float* const outp = A->out; float* const mod = (float*)(ws + WS_MOD); bf16* const act = (bf16*)(ws + WS_ACT); (void)outp; (void)mod; (void)act
    if (IN(0)) { p0_prologue(F); } SEAM(0);
    if (IN(1)) { PHASE_PTRS; norm_mod_pass(F, A->in[0], A->in[5], mod + 0, mod + 1024); } SEAM(1);
#pragma unroll
    for (int g = 0; g < NG; ++g) {
        if (IN(2 + 2 * g)) { PHASE_PTRS;
            pg8::Gemm gm{act, (const bf16*)(ws + WS_WQKV) + (size_t)g * 3072 * 1024, M, 3072, 1024}; pg8::StaticOrder S; S.init(M, 3072, F.G, (int)blockIdx.x);
            pg8::EpiQKV E{(bf16*)(ws + WS_BIG), 2 * g};
            pg8::gemm_phase<pg8::EpiQKV, pg8::StaticOrder, true, true>(F.lds, gm, S, E);
        } SEAM(2 + 2 * g);
        if (IN(3 + 2 * g)) { attn_naive(F, g); } SEAM(3 + 2 * g);
    }
    if (IN(8)) { PHASE_PTRS;
        pg8::Gemm gm{act, (const bf16*)(ws + WS_WO), M, 1024, 1024}; pg8::StaticOrder S; S.init(M, 1024, F.G, (int)blockIdx.x);
        pg8::EpiRes E{A->in[0], outp, mod + 2048};
        pg8::gemm_phase<pg8::EpiRes, pg8::StaticOrder, true, true>(F.lds, gm, S, E);
    } SEAM(8);
#pragma unroll
    for (int l = 0; l < 2; ++l) {
        const int p0 = l == 0 ? 9 : 16;
        if (IN(p0)) { PHASE_PTRS; float* const modl = mod + (size_t)l * 4 * 6144; norm_mod_pass(F, outp, A->in[6] + l * 1024, modl + 3072, modl + 4096); } SEAM(p0);
        if (IN(p0 + 1)) { PHASE_PTRS;
            pg8::Gemm gm{act, (const bf16*)(ws + (l ? WS_W13_1 : WS_W13_0)), M, NUP, 1024}; pg8::StaticOrder S; S.init(M, NUP, F.G, (int)blockIdx.x);
            pg8::EpiSwiGLU E{(bf16*)(ws + WS_BIG), FF};
            pg8::gemm_phase<pg8::EpiSwiGLU, pg8::StaticOrder, true, true>(F.lds, gm, S, E);
        } SEAM(p0 + 1);
        if (IN(p0 + 2)) { PHASE_PTRS; float* const modl = mod + (size_t)l * 4 * 6144;
            pg8::Gemm gm{(const bf16*)(ws + WS_BIG), (const bf16*)(ws + (l ? WS_W2_1 : WS_W2_0)), M, 1024, FF}; pg8::StaticOrder S; S.init(M, 1024, F.G, (int)blockIdx.x);
            pg8::EpiRes E{outp, outp, modl + 5120};
            pg8::gemm_phase<pg8::EpiRes, pg8::StaticOrder, true, true>(F.lds, gm, S, E);
        } SEAM(p0 + 2);
        if (l == 0) {
            if (IN(12)) { PHASE_PTRS; float* const mod1 = mod + (size_t)4 * 6144; norm_mod_pass(F, outp, A->in[5] + 1024, mod1 + 0, mod1 + 1024); } SEAM(12);
            if (IN(13)) { PHASE_PTRS;
                pg8::Gemm gm{act, (const bf16*)(ws + WS_WIN), M, 4096, 1024}; pg8::StaticOrder S; S.init(M, 4096, F.G, (int)blockIdx.x);
                pg8::EpiHgrnNaive E{(bf16*)(ws + WS_BIG), (float*)(ws + WS_BIG + 32 * MiB), (bf16*)(ws + WS_R2), (bf16*)(ws + WS_SG), (const float*)(ws + WS_LBS)};
                pg8::gemm_phase<pg8::EpiHgrnNaive, pg8::StaticOrder, true, true>(F.lds, gm, S, E);
            } SEAM(13);
            if (IN(14)) { hgrn_naive(F); } SEAM(14);
            if (IN(15)) { PHASE_PTRS; float* const mod1 = mod + (size_t)4 * 6144;
                pg8::Gemm gm{act, (const bf16*)(ws + WS_WHO), M, 1024, 1024}; pg8::StaticOrder S; S.init(M, 1024, F.G, (int)blockIdx.x);
                pg8::EpiRes E{outp, outp, mod1 + 2048};
                pg8::gemm_phase<pg8::EpiRes, pg8::StaticOrder, true, true>(F.lds, gm, S, E);
            } SEAM(15);
        }
    }
#undef IN
#undef SEAM
}

#ifndef MK_PER_PHASE
#define MK_PER_PHASE 0
#endif
extern "C" void kernel_launch(void* const* d_in, const int* in_sizes, int n_in, void* d_out, int out_size, void* d_ws, size_t ws_size, hipStream_t stream) {
    static int grid = 0;
    if (grid == 0) {
        if (n_in != 18 || in_sizes[0] != M * D || out_size != M * D || ws_size < WS_END) { fprintf(stderr, "kernel_launch: unexpected shapes (n_in %d, in0 %d, out %d, ws %zu); nothing launched\n", n_in, n_in > 0 ? in_sizes[0] : -1, out_size, ws_size); grid = -1; return; }
        int dev = 0, cus = 0, per_cu = 0;
        if (hipGetDevice(&dev) != hipSuccess || hipDeviceGetAttribute(&cus, hipDeviceAttributeMultiprocessorCount, dev) != hipSuccess) { grid = -1; return; }
        if (hipFuncSetAttribute((const void*)mk_fwd, hipFuncAttributeMaxDynamicSharedMemorySize, LDS_BYTES) != hipSuccess) { fprintf(stderr, "kernel_launch: hipFuncSetAttribute failed\n"); grid = -1; return; }
        if (hipOccupancyMaxActiveBlocksPerMultiprocessor(&per_cu, (const void*)mk_fwd, NWAVES * 64, LDS_BYTES) != hipSuccess || per_cu < 1) { fprintf(stderr, "kernel_launch: occupancy query says %d blocks per CU\n", per_cu); (void)hipGetLastError(); grid = -1; return; }
        grid = cus;
    }
    if (grid < 0) return;
    if (hipMemsetAsync((char*)d_ws + WS_CTL, 0, CTL_ZERO_BYTES, stream) != hipSuccess) return;
    Args a{};
    for (int i = 0; i < 18; ++i) a.in[i] = (const float*)d_in[i];
    a.out = (float*)d_out; a.ws = (unsigned char*)d_ws;
#if MK_PER_PHASE
    for (int p = 0; p < NPHASE; ++p) { a.ph_lo = p; a.ph_hi = p + 1; hipLaunchKernelGGL(mk_fwd, dim3(grid), dim3(NWAVES * 64), LDS_BYTES, stream, a); }
#else
    a.ph_lo = 0; a.ph_hi = NPHASE; hipLaunchKernelGGL(mk_fwd, dim3(grid), dim3(NWAVES * 64), LDS_BYTES, stream, a);
#endif
}
```

```cpp
#include <hip/hip_runtime.h>
#include <cstdio>
#include <cstdint>
#include <cmath>

__device__ __forceinline__ int fresh_lane() { unsigned z = 0u; asm volatile("" : "+s"(z)); return (int)__builtin_amdgcn_mbcnt_hi(~0u, __builtin_amdgcn_mbcnt_lo(~0u, z)); }
__device__ __forceinline__ int fresh_tid(int wave) { return wave * 64 + fresh_lane(); }

namespace pg8 {
#define PG8_LAS __attribute__((address_space(3)))
typedef unsigned short bf16_t;
typedef short bf16x8 __attribute__((ext_vector_type(8)));
typedef float f32x4 __attribute__((ext_vector_type(4)));
typedef unsigned u32x4 __attribute__((ext_vector_type(4)));
constexpr int BM = 256, BK = 64, HALF = 128, HTB = HALF * BK * 2  , STAGE_BYTES = 8 * HTB, NXCD = 8, WGM = 8;

__host__ __device__ __forceinline__ int lds_byte(int r, int c) { const int st = (r >> 4) * 2 + (c >> 5), rr = r & 15, cc = c & 31, ob = rr * 64 + cc * 2; return st * 1024 + (ob ^ (((ob >> 9) & 1) << 5)); }
__host__ __device__ __forceinline__ void stage_rc(int b, int& R, int& C) { const int st = b / 1024, sb = b % 1024, swz = sb ^ (((sb >> 9) & 1) << 5); R = (st >> 1) * 16 + swz / 64; C = (st & 1) * 32 + (swz % 64) / 2; }
__host__ __device__ __forceinline__ int perm32(int rho) { const int n = rho >> 4, i = rho & 15; return 8 * (i >> 2) + 4 * n + (i & 3); }

struct Unit { int pm, pn; };
struct Gemm { const bf16_t* A; const bf16_t* Bt; int M, N, K; };

struct StaticOrder {
    int nM, nN, nwg, G, c;
    __host__ __device__ void init(int M, int N, int G_, int c_) { nM = M / BM; nN = N / BM; nwg = nM * nN; G = G_; c = c_; }
    __host__ __device__ bool next(int i, Unit& u) const {
        const long L = (long)i * G + c; if (L >= nwg) return false;
        int wgid = (int)L; { const int q = nwg / NXCD, r = nwg % NXCD, xcd = wgid % NXCD, off = wgid / NXCD; wgid = (xcd < r ? xcd * (q + 1) : r * (q + 1) + (xcd - r) * q) + off; }
        const int nig = WGM * nN, gid = wgid / nig, fm = gid * WGM, gsz = (nM - fm) < WGM ? (nM - fm) : WGM;
        u.pm = fm + ((wgid % nig) % gsz); u.pn = (wgid % nig) / gsz; return true;
    }
    __device__ __forceinline__ void a_ready(const Unit&) const {}
    __device__ __forceinline__ void done(const Unit&) const {}
};


__device__ __forceinline__ unsigned cvt_pk_bf16(float lo, float hi) { unsigned r; asm volatile("v_cvt_pk_bf16_f32 %0, %1, %2" : "=v"(r) : "v"(lo), "v"(hi)); return r; }
__device__ __forceinline__ float silu_f(float a) { return a * __builtin_amdgcn_rcpf(1.0f + __expf(-a)); }
__device__ __forceinline__ float sigmoid_f(float a) { return __builtin_amdgcn_rcpf(1.0f + __expf(-a)); }
__device__ __forceinline__ u32x4 pack8(const f32x4 a, const f32x4 b) { u32x4 w; w.x = cvt_pk_bf16(a[0], a[1]); w.y = cvt_pk_bf16(a[2], a[3]); w.z = cvt_pk_bf16(b[0], b[1]); w.w = cvt_pk_bf16(b[2], b[3]); return w; }

struct EpiQKV {
    static constexpr bool PERM = true, AFTER_DRAIN = false;
    bf16_t* base; int dl;
    __device__ __forceinline__ void operator()(const f32x4 (&acc)[2][2][4][2], const Unit& u, int wr, int wc, int fr, int fq) const {
        const int which = u.pn >> 2, h0 = (u.pn & 3) * 2, dcol = wc * 32 + 8 * fq;
        bf16_t* ob = base + (size_t)which * (size_t)(4 * 8 * 4096 * 128);
        const int row0 = u.pm * BM + wr * 64 + fr;
#pragma unroll
        for (int ai = 0; ai < 2; ++ai)
#pragma unroll
            for (int m = 0; m < 4; ++m) { const int row = row0 + ai * HALF + m * 16, b = row >> 12, t = row & 4095;
                const int sp = ((t & ((1 << dl) - 1)) << (12 - dl)) + (t >> dl);
#pragma unroll
                for (int bj = 0; bj < 2; ++bj) { bf16_t* p = ob + ((size_t)((b * 8 + h0 + bj) * 4096 + sp)) * 128 + dcol;
                    *(u32x4*)p = pack8(acc[ai][bj][m][0], acc[ai][bj][m][1]); } }
    }
};
struct EpiRes {
    static constexpr bool PERM = false, AFTER_DRAIN = false;
    const float* base; float* out; const float* gate;
    __device__ __forceinline__ void operator()(const f32x4 (&acc)[2][2][4][2], const Unit& u, int wr, int wc, int fr, int fq) const {
        const int row0 = u.pm * BM + wr * 64 + fr, col0 = u.pn * BM + wc * 32 + 4 * fq, b = (u.pm * BM) >> 12;
        f32x4 gv[2][2];
#pragma unroll
        for (int bj = 0; bj < 2; ++bj)
#pragma unroll
            for (int n = 0; n < 2; ++n) gv[bj][n] = *(const f32x4*)(gate + b * 6144 + col0 + bj * HALF + n * 16);
#pragma unroll
        for (int ai = 0; ai < 2; ++ai)
#pragma unroll
            for (int m = 0; m < 4; ++m) { const size_t off = (size_t)(row0 + ai * HALF + m * 16) * 1024 + col0;
#pragma unroll
                for (int bj = 0; bj < 2; ++bj)
#pragma unroll
                    for (int n = 0; n < 2; ++n) { const f32x4 bs = *(const f32x4*)(base + off + bj * HALF + n * 16);
                        *(f32x4*)(out + off + bj * HALF + n * 16) = bs + gv[bj][n] * acc[ai][bj][m][n]; } }
    }
};
struct EpiSwiGLU {
    static constexpr bool PERM = true, AFTER_DRAIN = false;
    bf16_t* H; int ldh;
    __device__ __forceinline__ void operator()(const f32x4 (&acc)[2][2][4][2], const Unit& u, int wr, int wc, int fr, int fq) const {
        const int row0 = u.pm * BM + wr * 64 + fr, col0 = u.pn * HALF + wc * 32 + 8 * fq;
#pragma unroll
        for (int ai = 0; ai < 2; ++ai)
#pragma unroll
            for (int m = 0; m < 4; ++m) { f32x4 r0, r1;
#pragma unroll
                for (int i = 0; i < 4; ++i) { r0[i] = silu_f(acc[ai][0][m][0][i]) * acc[ai][1][m][0][i]; r1[i] = silu_f(acc[ai][0][m][1][i]) * acc[ai][1][m][1][i]; }
                *(u32x4*)(H + (size_t)(row0 + ai * HALF + m * 16) * ldh + col0) = pack8(r0, r1); }
    }
};
struct EpiHgrnNaive {
    static constexpr bool PERM = true, AFTER_DRAIN = false;
    bf16_t* QS; float* FG; bf16_t* V; bf16_t* SG; const float* lbs;
    __device__ __forceinline__ void operator()(const f32x4 (&acc)[2][2][4][2], const Unit& u, int wr, int wc, int fr, int fq) const {
        typedef unsigned u32x2 __attribute__((ext_vector_type(2)));
        const int head = u.pn >> 1, type = u.pn & 1, col0 = head * 128 + wc * 32 + 8 * fq, row0 = u.pm * BM + wr * 64 + fr;
#pragma unroll
        for (int n = 0; n < 2; ++n) {
            const f32x4 lb = *(const f32x4*)(lbs + col0 + 4 * n);
#pragma unroll
            for (int ai = 0; ai < 2; ++ai)
#pragma unroll
                for (int m = 0; m < 4; ++m) { const size_t off = (size_t)(row0 + ai * HALF + m * 16) * 1024 + col0 + 4 * n; f32x4 a, b;
                    if (type == 0) {
#pragma unroll
                        for (int i = 0; i < 4; ++i) { a[i] = silu_f(acc[ai][0][m][n][i]); b[i] = lb[i] + (1.0f - lb[i]) * sigmoid_f(acc[ai][1][m][n][i]); }
                        u32x2 w; w.x = cvt_pk_bf16(a[0], a[1]); w.y = cvt_pk_bf16(a[2], a[3]); *(u32x2*)(QS + off) = w; *(f32x4*)(FG + off) = b;
                    } else {
#pragma unroll
                        for (int i = 0; i < 4; ++i) { a[i] = acc[ai][0][m][n][i]; b[i] = silu_f(acc[ai][1][m][n][i]); }
                        u32x2 w; w.x = cvt_pk_bf16(a[0], a[1]); w.y = cvt_pk_bf16(a[2], a[3]); *(u32x2*)(V + off) = w;
                        u32x2 x; x.x = cvt_pk_bf16(b[0], b[1]); x.y = cvt_pk_bf16(b[2], b[3]); *(u32x2*)(SG + off) = x;
                    }
                    asm volatile("" ::: "memory"); }
        }
    }
};

template <class Epi, class Sched, bool ALIGN_EPI = false, bool SP2 = false>
__device__ __forceinline__ void gemm_phase(PG8_LAS unsigned char* lds, const Gemm g, const Sched& S, const Epi& E, const int wave_) {
    const int tid_ = fresh_tid(__builtin_amdgcn_readfirstlane(wave_));
    const int tid = tid_, wid = __builtin_amdgcn_readfirstlane(tid >> 6), lane = tid & 63, wr = wid >> 2, wc = wid & 3, fr = lane & 15, fq = lane >> 4;
    const int K = g.K, nt = K / BK;
    unsigned voffA[2], voffB[2];
#pragma unroll
    for (int i = 0; i < 2; ++i) { int R, C; stage_rc(tid * 16 + i * 8192, R, C); const int Rb = Epi::PERM ? ((R & ~31) + perm32(R & 31)) : R;
        voffA[i] = (unsigned)(R * K + C) * 2u; voffB[i] = (unsigned)(Rb * K + C) * 2u; }
    const size_t kstep = (size_t)(BK * 2);
    const size_t hstep = (size_t)HALF * K * 2;
    const size_t tstep = 2 * hstep;
    const unsigned ldsw = (unsigned)wid * 1024u;
    const int aoff = lds_byte(wr * 64 + fr, fq * 8), boff = lds_byte(wc * 32 + fr, fq * 8);
#define PG8_SA(b, h) (((b) * 2 + (h)) * HTB)
#define PG8_SB(b, h) ((4 + (b) * 2 + (h)) * HTB)
#define PG8_STAGE(bufoff, gbase, voff) do { _Pragma("unroll") for (int _i = 0; _i < 2; ++_i) \
        __builtin_amdgcn_global_load_lds((const unsigned*)((const char*)(gbase) + (voff)[_i]), (PG8_LAS unsigned*)(lds + (bufoff) + ldsw + _i * 8192), 16, 0, 0); } while (0)
#define PG8_LDA(dst, b, h) do { _Pragma("unroll") for (int m = 0; m < 4; ++m) _Pragma("unroll") for (int k = 0; k < 2; ++k) dst[m][k] = *(const PG8_LAS bf16x8*)(lds + PG8_SA(b, h) + aoff + m * 2048 + k * 1024); } while (0)
#define PG8_LDB(dst, b, h) do { _Pragma("unroll") for (int n = 0; n < 2; ++n) _Pragma("unroll") for (int k = 0; k < 2; ++k) dst[n][k] = *(const PG8_LAS bf16x8*)(lds + PG8_SB(b, h) + boff + n * 2048 + k * 1024); } while (0)
#define PG8_MMA(ai, bj, At, Bt) do { __builtin_amdgcn_s_setprio(1); _Pragma("unroll") for (int m = 0; m < 4; ++m) _Pragma("unroll") for (int n = 0; n < 2; ++n) _Pragma("unroll") for (int k = 0; k < 2; ++k) \
        acc[ai][bj][m][n] = __builtin_amdgcn_mfma_f32_16x16x32_bf16(Bt[n][k], At[m][k], acc[ai][bj][m][n], 0, 0, 0); __builtin_amdgcn_s_setprio(0); } while (0)
#define PG8_WAIT_V(n) asm volatile("s_waitcnt vmcnt(" #n ")" ::: "memory")
#define PG8_WAIT_L(n) asm volatile("s_waitcnt lgkmcnt(" #n ")" ::: "memory")
#define PG8_BAR __builtin_amdgcn_s_barrier()
#define PG8_SCHED __builtin_amdgcn_sched_barrier(0)
    Unit cur, nxt; int ui = 0;
    if (!S.next(0, cur)) return;
    f32x4 acc[2][2][4][2];
#pragma unroll
    for (int a = 0; a < 2; ++a)
#pragma unroll
        for (int b = 0; b < 2; ++b)
#pragma unroll
            for (int m = 0; m < 4; ++m)
#pragma unroll
                for (int n = 0; n < 2; ++n) acc[a][b][m][n] = (f32x4){0.f, 0.f, 0.f, 0.f};
    bf16x8 At[4][2], B0[2][2], B1[2][2];
    const char* cA = (const char*)g.A + (size_t)cur.pm * tstep; const char* cB = (const char*)g.Bt + (size_t)cur.pn * tstep;
    S.a_ready(cur);
    if constexpr (SP2) {
        PG8_STAGE(PG8_SB(0, 0), cB, voffB); PG8_STAGE(PG8_SB(0, 1), cB + hstep, voffB); PG8_STAGE(PG8_SA(0, 0), cA, voffA); PG8_STAGE(PG8_SA(0, 1), cA + hstep, voffA);
        if (wr == 1) PG8_BAR;
        PG8_WAIT_V(2); PG8_BAR;
        PG8_STAGE(PG8_SB(1, 0), cB + kstep, voffB); PG8_STAGE(PG8_SA(1, 0), cA + kstep, voffA); PG8_STAGE(PG8_SB(1, 1), cB + hstep + kstep, voffB);
        PG8_WAIT_V(6); PG8_BAR;
    } else {
        PG8_STAGE(PG8_SB(0, 0), cB, voffB); PG8_STAGE(PG8_SA(0, 0), cA, voffA); PG8_STAGE(PG8_SB(0, 1), cB + hstep, voffB); PG8_STAGE(PG8_SA(0, 1), cA + hstep, voffA);
        if (wr == 1) PG8_BAR;
        PG8_WAIT_V(4); PG8_BAR;
        PG8_STAGE(PG8_SB(1, 0), cB + kstep, voffB); PG8_STAGE(PG8_SA(1, 0), cA + kstep, voffA); PG8_STAGE(PG8_SB(1, 1), cB + hstep + kstep, voffB);
        PG8_WAIT_V(6); PG8_BAR;
    }
    for (;;) {
        const bool has_next = S.next(ui + 1, nxt);
        const char* nA = has_next ? (const char*)g.A + (size_t)nxt.pm * tstep : cA; const char* nB = has_next ? (const char*)g.Bt + (size_t)nxt.pn * tstep : cB;
        for (int t = 0; t < nt; t += 2) {
            const bool last = (t == nt - 2);
            const char* a1 = cA + (size_t)(t + 1) * kstep;
            const char* a2 = last ? nA : cA + (size_t)(t + 2) * kstep; const char* b2 = last ? nB : cB + (size_t)(t + 2) * kstep;
            const char* a3 = a2 + kstep; const char* b3 = b2 + kstep;
            if (last && has_next) S.a_ready(nxt);
            if constexpr (SP2) {
            PG8_LDB(B0, 0, 0); PG8_LDB(B1, 0, 1); PG8_SCHED; PG8_LDA(At, 0, 0); PG8_STAGE(PG8_SA(1, 1), a1 + hstep, voffA);
            PG8_WAIT_V(8); PG8_WAIT_L(0); PG8_BAR; PG8_MMA(0, 0, At, B0); PG8_MMA(0, 1, At, B1); PG8_BAR; PG8_SCHED;
            PG8_LDA(At, 0, 1); PG8_STAGE(PG8_SB(0, 0), b2, voffB); PG8_STAGE(PG8_SB(0, 1), b2 + hstep, voffB); PG8_STAGE(PG8_SA(0, 0), a2, voffA);
            PG8_WAIT_V(8); PG8_WAIT_L(0); PG8_BAR; PG8_MMA(1, 0, At, B0); PG8_MMA(1, 1, At, B1); PG8_BAR; PG8_SCHED;
            PG8_LDB(B0, 1, 0); PG8_LDB(B1, 1, 1); PG8_SCHED; PG8_LDA(At, 1, 0); PG8_STAGE(PG8_SA(0, 1), a2 + hstep, voffA);
            PG8_WAIT_V(8); PG8_WAIT_L(0); PG8_BAR; PG8_MMA(0, 0, At, B0); PG8_MMA(0, 1, At, B1); PG8_BAR; PG8_SCHED;
            PG8_LDA(At, 1, 1); PG8_STAGE(PG8_SB(1, 0), b3, voffB); PG8_STAGE(PG8_SB(1, 1), b3 + hstep, voffB); PG8_STAGE(PG8_SA(1, 0), a3, voffA);
            PG8_WAIT_V(8); PG8_WAIT_L(0); PG8_BAR; PG8_MMA(1, 0, At, B0); PG8_MMA(1, 1, At, B1); PG8_BAR; PG8_SCHED;
            } else {
            PG8_LDB(B0, 0, 0); PG8_SCHED; PG8_LDA(At, 0, 0); PG8_STAGE(PG8_SA(1, 1), a1 + hstep, voffA);
            PG8_WAIT_L(8); PG8_BAR; PG8_WAIT_L(0); PG8_MMA(0, 0, At, B0); PG8_BAR; PG8_SCHED;
            PG8_LDB(B1, 0, 1); PG8_STAGE(PG8_SB(0, 0), b2, voffB);
            PG8_BAR; PG8_WAIT_L(0); PG8_MMA(0, 1, At, B1); PG8_BAR;
            PG8_LDA(At, 0, 1); PG8_STAGE(PG8_SA(0, 0), a2, voffA);
            PG8_BAR; PG8_WAIT_L(0); PG8_MMA(1, 0, At, B0); PG8_BAR; PG8_SCHED;
            PG8_STAGE(PG8_SB(0, 1), b2 + hstep, voffB);
            PG8_WAIT_V(6); PG8_BAR; PG8_MMA(1, 1, At, B1); PG8_BAR;
            PG8_LDB(B0, 1, 0); PG8_SCHED; PG8_LDA(At, 1, 0); PG8_STAGE(PG8_SA(0, 1), a2 + hstep, voffA);
            PG8_WAIT_L(8); PG8_BAR; PG8_WAIT_L(0); PG8_MMA(0, 0, At, B0); PG8_BAR; PG8_SCHED;
            PG8_LDB(B1, 1, 1); PG8_STAGE(PG8_SB(1, 0), b3, voffB);
            PG8_BAR; PG8_WAIT_L(0); PG8_MMA(0, 1, At, B1); PG8_BAR;
            PG8_LDA(At, 1, 1); PG8_STAGE(PG8_SA(1, 0), a3, voffA);
            PG8_BAR; PG8_WAIT_L(0); PG8_MMA(1, 0, At, B0); PG8_BAR; PG8_SCHED;
            PG8_STAGE(PG8_SB(1, 1), b3 + hstep, voffB);
            PG8_WAIT_V(6); PG8_BAR; PG8_MMA(1, 1, At, B1); PG8_BAR;
            }
        }
        if constexpr (ALIGN_EPI) { if (wr == 0) PG8_BAR; }
        if constexpr (!Epi::AFTER_DRAIN) { E(acc, cur, wr, wc, fr, fq); S.done(cur); }
        if (!has_next) break;
#pragma unroll
        for (int a = 0; a < 2; ++a)
#pragma unroll
            for (int b = 0; b < 2; ++b)
#pragma unroll
                for (int m = 0; m < 4; ++m)
#pragma unroll
                    for (int n = 0; n < 2; ++n) acc[a][b][m][n] = (f32x4){0.f, 0.f, 0.f, 0.f};
        cur = nxt; cA = nA; cB = nB; ++ui;
        if constexpr (ALIGN_EPI) { if (wr == 1) PG8_BAR; }
    }
    PG8_WAIT_V(0);
    if constexpr (!ALIGN_EPI) { if (wr == 0) PG8_BAR; }
    PG8_BAR;
    if constexpr (Epi::AFTER_DRAIN) { E.fused(acc, cur, wr, wc, fr, fq, lds, wid, lane); S.done(cur); }
#undef PG8_SA
#undef PG8_SB
#undef PG8_STAGE
#undef PG8_LDA
#undef PG8_LDB
#undef PG8_MMA
#undef PG8_WAIT_V
#undef PG8_WAIT_L
#undef PG8_BAR
#undef PG8_SCHED
}
}
#define GAS __attribute__((address_space(1)))
#define LAS __attribute__((address_space(3)))
typedef unsigned short bf16;
typedef unsigned v4u __attribute__((ext_vector_type(4)));
typedef float f32x4 __attribute__((ext_vector_type(4)));
typedef short bf16x8 __attribute__((ext_vector_type(8)));
typedef GAS unsigned gu32;
typedef GAS unsigned long long gu64;
#define RLX_AGENT __ATOMIC_RELAXED, __HIP_MEMORY_SCOPE_AGENT
#define LDS_WAIT() asm volatile("s_waitcnt lgkmcnt(0)" ::: "memory")
#define VM_WAIT() asm volatile("s_waitcnt vmcnt(0)" ::: "memory")
__device__ __forceinline__ unsigned long long rt() { return __builtin_amdgcn_s_memrealtime(); }
__device__ __forceinline__ unsigned f2bf(float f) { unsigned u = __builtin_bit_cast(unsigned, f); return (u + 0x7fffu + ((u >> 16) & 1u)) >> 16; }
__device__ __forceinline__ unsigned pk2(float lo, float hi) { return f2bf(lo) | (f2bf(hi) << 16); }

#define XB_TMO      128
#define XB_XCNT(j)  (256  + 64 * (j))
#define XB_XSUB(j)  (1280 + 64 * (j))
#define XB_XGEN(j)  (2304 + 64 * (j))
#define XB_TOP      3328
#define XB_TOPGEN   3392
#define XCD_BAR_WORDS 3456
#define XB_SPIN_CAP (1u << 18)

__device__ __forceinline__ unsigned xb_ld(unsigned* p)              { return __hip_atomic_load(p, __ATOMIC_RELAXED, __HIP_MEMORY_SCOPE_AGENT); }
__device__ __forceinline__ unsigned xb_add(unsigned* p, unsigned v) { return __hip_atomic_fetch_add(p, v, __ATOMIC_RELAXED, __HIP_MEMORY_SCOPE_AGENT); }
__device__ __forceinline__ unsigned xb_xcc_id() { return (unsigned)__builtin_amdgcn_s_getreg((3 << 11) | 20) & 0xFu; }
#define XB_SPIN(cond, bar) do { unsigned _sp = 0; while (cond) { __builtin_amdgcn_s_sleep(1); \
    if ((++_sp & 255u) == 0u) { if (xb_ld(&(bar)[XB_TMO])) break; if (_sp > XB_SPIN_CAP) { atomicAdd(&(bar)[XB_TMO], 1u); break; } } } } while (0)


struct XcdBarrier {
    unsigned* bar; unsigned x; int wave;
    volatile LAS unsigned* st;
};

__device__ __forceinline__ XcdBarrier xcd_barrier_post(unsigned* bar, volatile LAS unsigned* st, int wave) {
    XcdBarrier b; b.bar = bar; b.x = xb_xcc_id(); b.st = st; b.wave = wave;
    if (fresh_tid(wave) == 0) (void)xb_add(&bar[XB_XCNT(b.x)], 1u);
    return b;
}
__device__ __forceinline__ void xcd_barrier_complete(unsigned* bar, unsigned x, unsigned& nloc, unsigned& nx) {
    const unsigned G = gridDim.x * gridDim.y * gridDim.z;
    unsigned sum, cnt, mine, sp = 0u;
    for (;;) {
        sum = 0u; cnt = 0u; mine = 0u;
#pragma unroll
        for (unsigned j = 0; j < 16; ++j) { const unsigned c = xb_ld(&bar[XB_XCNT(j)]); sum += c; cnt += (c > 0u) ? 1u : 0u; mine = (j == x) ? c : mine; }
        if (sum == G) break;
        __builtin_amdgcn_s_sleep(1);
        if ((++sp & 255u) == 0u) { if (xb_ld(&bar[XB_TMO])) break; if (sp > XB_SPIN_CAP) { atomicAdd(&bar[XB_TMO], 1u); break; } }
    }
    nloc = mine > 0u ? mine : 1u; nx = cnt > 0u ? cnt : 1u;
}

__device__ __forceinline__ void xcd_barrier(const XcdBarrier& b) {
    asm volatile("s_waitcnt vmcnt(0)" ::: "memory");
    __syncthreads();
    if (fresh_tid(b.wave) == 0) {
        unsigned* bar = b.bar;
        __builtin_amdgcn_s_waitcnt(0);
        unsigned nloc = b.st[0], nx = b.st[1];
        if (nloc == 0u) { xcd_barrier_complete(bar, b.x, nloc, nx); b.st[0] = nloc; b.st[1] = nx; }
        const unsigned old = xb_add(&bar[XB_XSUB(b.x)], 1u);
        const unsigned gen = old / nloc;
        if (old + 1u == (gen + 1u) * nloc) {
            __builtin_amdgcn_fence(__ATOMIC_RELEASE, "agent");
            asm volatile("s_waitcnt vmcnt(0)" ::: "memory");
            const unsigned og = xb_add(&bar[XB_TOP], 1u);
            const unsigned tg = og / nx;
            if (og + 1u == (tg + 1u) * nx) xb_add(&bar[XB_TOPGEN], 1u);
            else XB_SPIN(xb_ld(&bar[XB_TOPGEN]) == tg, bar);
            __builtin_amdgcn_fence(__ATOMIC_ACQUIRE, "agent");
            xb_add(&bar[XB_XGEN(b.x)], 1u);
            asm volatile("s_waitcnt vmcnt(0)" ::: "memory");
        } else {
            XB_SPIN(xb_ld(&bar[XB_XGEN(b.x)]) == gen, bar);
            __builtin_amdgcn_fence(__ATOMIC_ACQUIRE, "agent");
            asm volatile("s_waitcnt vmcnt(0)" ::: "memory");
        }
    }
    __syncthreads();
}

namespace att {
#define ATT_LAS __attribute__((address_space(3)))
typedef unsigned short bf16_t;
typedef short bf16x8 __attribute__((ext_vector_type(8)));
typedef short s16x4 __attribute__((ext_vector_type(4)));
typedef float f32x16 __attribute__((ext_vector_type(16)));
typedef float f32x4 __attribute__((ext_vector_type(4)));
typedef unsigned u32x4 __attribute__((ext_vector_type(4)));
typedef ATT_LAS char* lptr;
constexpr int D = 128, NW = 8, QBLK = 32, KVBLK = 64, QB = NW * QBLK, W = 129;
constexpr int SHM_V = KVBLK * D * 2, SHM_K = KVBLK * D * 2;
constexpr int LDS_WSC = 2 * SHM_V + 2 * SHM_K;
constexpr int LUTW = 320, LUT_OFF = 96;
constexpr int LDS_LUT = LDS_WSC + NW * 64 * 4;
constexpr int LDS_BYTES = LDS_LUT + 8 * LUTW * 4;
constexpr float SCALE = 0.08838834764831845f, THR = 0.f, EPS = 1e-6f;
constexpr bool SK = true;

#define KSWZ(row, colB) ((row) * 256 + ((colB) ^ (((row) & 7) << 4)))
#define SBAR() __builtin_amdgcn_sched_barrier(0)
__device__ __forceinline__ int v_st(int k, int c) { const int kk = (k & ~0xC) | ((k & 4) << 1) | ((k & 8) >> 1); return ((kk >> 3) * 4 + (c >> 5)) * 512 + ((kk & 7) * 32 + (c & 31)) * 2; }
__device__ __forceinline__ int v_rd_base(int lane) { return ((lane & 3) << 3) | (((lane >> 2) & 3) << 6) | (((lane >> 4) & 1) << 5) | (((lane >> 5) & 1) << 8); }
constexpr int v_rd_off(int d0, int ks, int half) { return d0 * 512 + ks * 4096 + half * 2048; }
__device__ __forceinline__ int crow(int r, int hi) { return (r & 3) + 8 * (r >> 2) + 4 * hi; }
__device__ __forceinline__ unsigned cvtpk(float lo, float hi) { unsigned r; asm volatile("v_cvt_pk_bf16_f32 %0, %1, %2" : "=v"(r) : "v"(lo), "v"(hi)); return r; }
__device__ __forceinline__ float bfe(bf16x8 v, int j) { return __builtin_bit_cast(float, (unsigned)(unsigned short)v[j] << 16); }
__device__ __forceinline__ float dpp_sum16(float v) {
    v += __builtin_bit_cast(float, __builtin_amdgcn_update_dpp(0, __builtin_bit_cast(int, v), 0xB1, 0xF, 0xF, false));
    v += __builtin_bit_cast(float, __builtin_amdgcn_update_dpp(0, __builtin_bit_cast(int, v), 0x4E, 0xF, 0xF, false));
    v += __builtin_bit_cast(float, __builtin_amdgcn_update_dpp(0, __builtin_bit_cast(int, v), 0x141, 0xF, 0xF, false));
    v += __builtin_bit_cast(float, __builtin_amdgcn_update_dpp(0, __builtin_bit_cast(int, v), 0x140, 0xF, 0xF, false));
    return v;
}
__device__ __forceinline__ bf16x8 knorm(bf16x8 k) {
    float f[8]; float ss = 0.f;
#pragma unroll
    for (int j = 0; j < 8; ++j) { f[j] = bfe(k, j); ss += f[j] * f[j]; }
    const float rs = __builtin_amdgcn_rsqf(dpp_sum16(ss) * (1.0f / D) + EPS);
    u32x4 w = {cvtpk(f[0] * rs, f[1] * rs), cvtpk(f[2] * rs, f[3] * rs), cvtpk(f[4] * rs, f[5] * rs), cvtpk(f[6] * rs, f[7] * rs)};
    return __builtin_bit_cast(bf16x8, w);
}
__device__ __forceinline__ void q_normalize(bf16x8* qr, const float* gq, int hi) {
    float ss = 0.f;
#pragma unroll
    for (int d0 = 0; d0 < 8; ++d0)
#pragma unroll
        for (int j = 0; j < 8; ++j) { const float f = bfe(qr[d0], j); ss += f * f; }
    { auto rr = __builtin_amdgcn_permlane32_swap(__float_as_uint(ss), __float_as_uint(ss), false, false); ss = __uint_as_float(rr[0]) + __uint_as_float(rr[1]); }
    const float rs = __builtin_amdgcn_rsqf(ss * (1.0f / D) + EPS);
#pragma unroll
    for (int d0 = 0; d0 < 8; ++d0) { const f32x4 g0 = *(const f32x4*)((const char*)gq + (unsigned)(hi * 32) + d0 * 64), g1 = *(const f32x4*)((const char*)gq + (unsigned)(hi * 32) + d0 * 64 + 16);
        u32x4 w = {cvtpk(bfe(qr[d0], 0) * rs * g0[0], bfe(qr[d0], 1) * rs * g0[1]), cvtpk(bfe(qr[d0], 2) * rs * g0[2], bfe(qr[d0], 3) * rs * g0[3]),
                   cvtpk(bfe(qr[d0], 4) * rs * g1[0], bfe(qr[d0], 5) * rs * g1[1]), cvtpk(bfe(qr[d0], 6) * rs * g1[2], bfe(qr[d0], 7) * rs * g1[3])};
        qr[d0] = __builtin_bit_cast(bf16x8, w); }
}
__device__ __forceinline__ void mask_tile(f32x16& p0, f32x16& p1, int dq, unsigned Wn) {
    const float NEG = -__builtin_inff();
#pragma unroll
    for (int r = 0; r < 16; ++r) { const int c = (r & 3) + 8 * (r >> 2);
        if ((unsigned)(dq - c) >= Wn) p0[r] = NEG;
        if ((unsigned)(dq - c - 32) >= Wn) p1[r] = NEG; }
}
__device__ __forceinline__ void bias_tile(f32x16& p0, f32x16& p1, const ATT_LAS float* lb) {
#pragma unroll
    for (int r = 0; r < 16; ++r) { const int c = (r & 3) + 8 * (r >> 2); p0[r] += lb[63 - c]; p1[r] += lb[31 - c]; }
}
__device__ __forceinline__ void partialSM(f32x16& p0, f32x16& p1, float& m_reg, float& mn, float& alpha) {
    float pmax = p0[0];
#pragma unroll
    for (int r = 1; r < 16; ++r) pmax = fmaxf(pmax, p0[r]);
#pragma unroll
    for (int r = 0; r < 16; ++r) pmax = fmaxf(pmax, p1[r]);
    { auto rr = __builtin_amdgcn_permlane32_swap(__float_as_uint(pmax), __float_as_uint(pmax), false, false);
      pmax = fmaxf(__uint_as_float(rr[0]), __uint_as_float(rr[1])); }
    constexpr float C2 = 1.4426950408889634f * SCALE;
    if (__builtin_expect(__all((pmax - m_reg) * SCALE <= THR), 1)) { mn = m_reg; alpha = 1.f; }
    else { mn = fmaxf(m_reg, pmax); alpha = __builtin_amdgcn_exp2f((m_reg - mn) * C2); m_reg = mn; }
    const float mnL = -mn * C2;
#pragma unroll
    for (int r = 0; r < 16; ++r) p0[r] = fmaf(p0[r], C2, mnL);
#pragma unroll
    for (int r = 0; r < 16; ++r) p1[r] = fmaf(p1[r], C2, mnL);
#pragma unroll
    for (int r = 0; r < 16; ++r) p0[r] = __builtin_amdgcn_exp2f(p0[r]);
}
__device__ __forceinline__ void finishSM(f32x16& p0, f32x16& p1, float alpha, float& l_reg, bf16x8& pa0, bf16x8& pa1, bf16x8& pa2, bf16x8& pa3) {
#pragma unroll
    for (int r = 0; r < 16; ++r) p1[r] = __builtin_amdgcn_exp2f(p1[r]);
    float ps = 0;
#pragma unroll
    for (int r = 0; r < 16; ++r) ps += p0[r];
#pragma unroll
    for (int r = 0; r < 16; ++r) ps += p1[r];
    { auto rr = __builtin_amdgcn_permlane32_swap(__float_as_uint(ps), __float_as_uint(ps), false, false);
      ps = __uint_as_float(rr[0]) + __uint_as_float(rr[1]); }
    l_reg = l_reg * alpha + ps;
#define PK4(P, B_, OUT) do { unsigned a0 = cvtpk(P[B_+0], P[B_+1]), a1 = cvtpk(P[B_+2], P[B_+3]);                          \
        unsigned b0 = cvtpk(P[B_+4], P[B_+5]), b1 = cvtpk(P[B_+6], P[B_+7]);                                             \
        auto r0 = __builtin_amdgcn_permlane32_swap(a0, b0, false, false); auto r1 = __builtin_amdgcn_permlane32_swap(a1, b1, false, false); \
        u32x4 w = {r0[0], r1[0], r0[1], r1[1]}; OUT = __builtin_bit_cast(bf16x8, w); } while (0)
    PK4(p0, 0, pa0); PK4(p0, 8, pa1); PK4(p1, 0, pa2); PK4(p1, 8, pa3);
#undef PK4
}
template <int KB>
__device__ __forceinline__ void qkt(f32x16& p0, f32x16& p1, lptr K_lds, int r32, int hi, const bf16x8* qr, bool act) {
    if (SK && !act) { const float NEG = -__builtin_inff();
#pragma unroll
        for (int r = 0; r < 16; ++r) { p0[r] = NEG; p1[r] = NEG; } return; }
    p0 = f32x16{}; p1 = f32x16{};
    lptr kb[4];
#pragma unroll
    for (int dd = 0; dd < 4; ++dd) kb[dd] = K_lds + KB * SHM_K + KSWZ(r32, (dd * 16 + hi * 8) * 2);
#pragma unroll
    for (int d0 = 0; d0 < 8; ++d0) { lptr a = kb[d0 & 3] + (d0 >> 2) * 128;
        bf16x8 b0 = *(const ATT_LAS bf16x8*)(a);
        bf16x8 b1 = *(const ATT_LAS bf16x8*)(a + 32 * 256);
        p0 = __builtin_amdgcn_mfma_f32_32x32x16_bf16(b0, qr[d0], p0, 0, 0, 0);
        p1 = __builtin_amdgcn_mfma_f32_32x32x16_bf16(b1, qr[d0], p1, 0, 0, 0); }
}
template <int VB>
__device__ __forceinline__ void pv_tile(f32x16* o, int vb0, bf16x8 pa0, bf16x8 pa1, bf16x8 pa2, bf16x8 pa3, bool act) {
    if (SK && !act) return;
#define TRRD(dst, off) asm volatile("ds_read_b64_tr_b16 %0, %1 offset:%2" : "=&v"(dst) : "v"(vb0), "i"(off) : "memory")
#define PV_D0(d0) do { s16x4 l0, l1, l2, l3, h0, h1, h2, h3; constexpr int b_ = VB * SHM_V + v_rd_off(d0, 0, 0); \
        TRRD(l0, b_); TRRD(h0, b_ + 2048); TRRD(l1, b_ + 4096); TRRD(h1, b_ + 6144); TRRD(l2, b_ + 8192); TRRD(h2, b_ + 10240); TRRD(l3, b_ + 12288); TRRD(h3, b_ + 14336); \
        asm volatile("s_waitcnt lgkmcnt(0)" ::: "memory"); SBAR();   \
        o[d0] = __builtin_amdgcn_mfma_f32_32x32x16_bf16(pa0, (bf16x8){l0[0], l0[1], l0[2], l0[3], h0[0], h0[1], h0[2], h0[3]}, o[d0], 0, 0, 0);   \
        o[d0] = __builtin_amdgcn_mfma_f32_32x32x16_bf16(pa1, (bf16x8){l1[0], l1[1], l1[2], l1[3], h1[0], h1[1], h1[2], h1[3]}, o[d0], 0, 0, 0);   \
        o[d0] = __builtin_amdgcn_mfma_f32_32x32x16_bf16(pa2, (bf16x8){l2[0], l2[1], l2[2], l2[3], h2[0], h2[1], h2[2], h2[3]}, o[d0], 0, 0, 0);   \
        o[d0] = __builtin_amdgcn_mfma_f32_32x32x16_bf16(pa3, (bf16x8){l3[0], l3[1], l3[2], l3[3], h3[0], h3[1], h3[2], h3[3]}, o[d0], 0, 0, 0); } while (0)
    PV_D0(0); PV_D0(1); PV_D0(2); PV_D0(3);
#undef PV_D0
#undef TRRD
}

struct BlockRef { const bf16_t* Q; const bf16_t* K; const bf16_t* V; bf16_t* O; float* LSE; int P0, lut; };
struct Seam { bf16x8 qr[8]; bf16x8 st_v0, st_v1, st_k0, st_k1; };
struct PhaseConst { int skv, ostr, lstr; const float* gq; };
__device__ __forceinline__ int swa_jlo(int P0) { const int lowk = P0 - W + 1; return lowk > 0 ? lowk / KVBLK : 0; }
#define ROW(p, k0, rr) ((const char*)((p) + (size_t)((k0) + (rr)) * D) + kvoff)
#define VMW() asm volatile("s_waitcnt vmcnt(0)" ::: "memory")
#define VMWN(n) asm volatile("s_waitcnt vmcnt(%0)" :: "i"(n) : "memory")
#define LD8(p) (*reinterpret_cast<const bf16x8*>(p))
#define QROWP(Qp, wid) ((const char*)((Qp) + (size_t)((wid) * QBLK) * D) + qoff)
#define SLOAD_H(Kp, Vp, k0) do { S.st_v0 = LD8(ROW(Vp, k0, 0)); S.st_v1 = LD8(ROW(Vp, k0, 32)); S.st_k0 = LD8(ROW(Kp, k0, 0)); S.st_k1 = LD8(ROW(Kp, k0, 32)); } while (0)
#define SWRITE_HK(bf) do { *(ATT_LAS bf16x8*)(K_lds + (bf) * SHM_K + kws) = knorm(S.st_k0); *(ATT_LAS bf16x8*)(K_lds + (bf) * SHM_K + kws + 32 * 256) = knorm(S.st_k1); } while (0)
#define SWRITE_HV(bf) do { *(ATT_LAS bf16x8*)(V_lds + (bf) * SHM_V + vst0) = S.st_v0; *(ATT_LAS bf16x8*)(V_lds + (bf) * SHM_V + vst0 + 8192) = S.st_v1;     } while (0)
#define SWRITE_H(bf) do { SWRITE_HV(bf); SWRITE_HK(bf); } while (0)
__device__ __forceinline__ void swa_prime(const BlockRef& cur, lptr lds, Seam& S, const int tid) {
    const int wid = __builtin_amdgcn_readfirstlane(tid >> 6), lane = tid & 63, r32 = lane & 31, hi = lane >> 5;
    const int sr = tid >> 4, sc = (tid & 15) * 8, kws = KSWZ(sr, sc * 2); lptr K_lds = lds + 2 * SHM_V;
    const unsigned kvoff = (unsigned)(sr * D + sc) * 2u, qoff = (unsigned)(r32 * D + hi * 8) * 2u;
    const int kb0 = swa_jlo(cur.P0) * KVBLK;
#pragma unroll
    for (int d0 = 0; d0 < 8; ++d0) S.qr[d0] = LD8(QROWP(cur.Q, wid) + d0 * 32);
    SLOAD_H(cur.K, cur.V, kb0); VMW(); SWRITE_HK(0);
    __syncthreads();
}
__device__ __forceinline__ void swa_block(const BlockRef& cur, const BlockRef& nxt, const PhaseConst& pc, lptr lds, Seam& S, const int tid) {
    const int wid = __builtin_amdgcn_readfirstlane(tid >> 6), lane = tid & 63, r32 = lane & 31, hi = lane >> 5;
    const int j_lo = swa_jlo(cur.P0);
    int j_hi = (cur.P0 + QB - 1) / KVBLK + 1; if (j_hi > pc.skv / KVBLK) j_hi = pc.skv / KVBLK;
    const int NT = j_hi - j_lo;
    const int kbn = swa_jlo(nxt.P0) * KVBLK;
    const int qlo = cur.P0 + wid * QBLK, qm = qlo + r32 - 4 * hi;
    lptr V_lds = lds; lptr K_lds = lds + 2 * SHM_V;
    ATT_LAS float* wsc = (ATT_LAS float*)(lds + LDS_WSC) + wid * 64; ATT_LAS float* li_l = wsc; ATT_LAS float* al_l = wsc + 32;
    const ATT_LAS float* lutq = (const ATT_LAS float*)(lds + LDS_LUT + cur.lut) + (LUT_OFF - 63) + qm;
    float m_reg = -1e30f, l_reg = 0; f32x16 o[4] = {};
    const int sr = tid >> 4, sc = (tid & 15) * 8, vst0 = v_st(sr, sc), kws = KSWZ(sr, sc * 2);
    const unsigned kvoff = (unsigned)(sr * D + sc) * 2u, qoff = (unsigned)(r32 * D + hi * 8) * 2u;
    const int vb0 = (int)(unsigned)(uintptr_t)V_lds + v_rd_base(lane);
    const bf16_t* Kh = cur.K; const bf16_t* Vh = cur.V;
    q_normalize(S.qr, pc.gq, hi);
#define RESC(a) do { if (__any((a) < 1.f)) { if (hi == 0) al_l[r32] = (a); asm volatile("s_waitcnt lgkmcnt(0)" ::: "memory");              \
                     _Pragma("unroll") for (int d_ = 0; d_ < 4; ++d_) _Pragma("unroll") for (int r = 0; r < 16; ++r) o[d_][r] *= al_l[crow(r, hi)]; } } while (0)
#define KBASE(t) ((j_lo + (t)) * KVBLK)
#define ACT(t) (KBASE(t) <= qlo + QBLK - 1 && KBASE(t) + KVBLK - 1 >= qlo - W + 1)
#define MASKT(P0_, P1_, t) do { const int kb_ = KBASE(t); if (ACT(t)) { bias_tile(P0_, P1_, lutq - kb_); \
        if (kb_ + KVBLK - 1 > qlo || kb_ <= qlo + QBLK - 1 - W) mask_tile(P0_, P1_, qm - kb_, (unsigned)W); } } while (0)
    constexpr int NQL = 8;
#define SEAM_K0() do { VMWN(NQL); SWRITE_HK(0); SBAR(); } while (0)
    f32x16 pA0, pA1, pB0, pB1; float mnA, mnB, alA, alB; bf16x8 pa0, pa1, pa2, pa3;
    SWRITE_HV(0); SBAR();
    if (NT > 1) { SLOAD_H(Kh, Vh, KBASE(1)); }
    SBAR(); qkt<0>(pA0, pA1, K_lds, r32, hi, S.qr, ACT(0));
    MASKT(pA0, pA1, 0); partialSM(pA0, pA1, m_reg, mnA, alA);
    if (NT > 1) { VMW(); SWRITE_H(1); }
    __syncthreads();
#define HALF_STEP(PX0, PX1, mnX, alX, PY0, PY1, alY, t, KB, VB, SB) do {                                                      \
        SBAR(); qkt<KB>(PX0, PX1, K_lds, r32, hi, S.qr, ACT(t));                                             \
        finishSM(PY0, PY1, alY, l_reg, pa0, pa1, pa2, pa3); SBAR();                                                           \
        if ((t) + 1 < NT) { SLOAD_H(Kh, Vh, KBASE((t) + 1)); SBAR(); }                                               \
        pv_tile<VB>(o, vb0, pa0, pa1, pa2, pa3, ACT((t) - 1)); MASKT(PX0, PX1, (t)); partialSM(PX0, PX1, m_reg, mnX, alX);                                        \
        __syncthreads();                                                                                                      \
        if ((t) + 1 < NT) { VMW(); SWRITE_H(SB); }                                                                          \
        RESC(alX); __syncthreads(); } while (0)
    for (int t = 1; t + 1 < NT; t += 2) {
        HALF_STEP(pB0, pB1, mnB, alB, pA0, pA1, alA, t, 1, 0, 0);
        HALF_STEP(pA0, pA1, mnA, alA, pB0, pB1, alB, t + 1, 0, 1, 1);
    }
    const bool even = (NT & 1) == 0;
    if (even) { SBAR(); qkt<1>(pB0, pB1, K_lds, r32, hi, S.qr, ACT(NT - 1)); SBAR(); }
    SLOAD_H(nxt.K, nxt.V, kbn); SBAR();
#pragma unroll
    for (int d0 = 0; d0 < 8; ++d0) S.qr[d0] = LD8(QROWP(nxt.Q, wid) + d0 * 32);
    SBAR();
    finishSM(pA0, pA1, alA, l_reg, pa0, pa1, pa2, pa3); SBAR();
    pv_tile<0>(o, vb0, pa0, pa1, pa2, pa3, ACT(even ? NT - 2 : NT - 1));
    if (even) { MASKT(pB0, pB1, NT - 1); partialSM(pB0, pB1, m_reg, mnB, alB); __syncthreads(); RESC(alB);
        finishSM(pB0, pB1, alB, l_reg, pa0, pa1, pa2, pa3); SBAR(); pv_tile<1>(o, vb0, pa0, pa1, pa2, pa3, ACT(NT - 1)); }
    SBAR(); SEAM_K0();
    if (hi == 0) { li_l[r32] = l_reg; *(float*)((char*)(cur.LSE + (size_t)(wid * QBLK) * pc.lstr) + (unsigned)(r32 * pc.lstr) * 4u) = m_reg * (1.4426950408889634f * SCALE) + __builtin_amdgcn_logf(l_reg); }
    asm volatile("s_waitcnt lgkmcnt(0)" ::: "memory");
    float rli[16];
#pragma unroll
    for (int r = 0; r < 16; ++r) rli[r] = __builtin_amdgcn_rcpf(li_l[crow(r, hi)]);
    char* Ow = (char*)(cur.O + (size_t)(wid * QBLK) * pc.ostr) + (unsigned)(r32 * 2); const unsigned ostrb = (unsigned)pc.ostr * 2u;
#pragma unroll
    for (int r = 0; r < 16; ++r) { const int orow = crow(r, hi);
#pragma unroll
        for (int d0 = 0; d0 < 4; ++d0) { const float v = o[d0][r] * rli[r]; const float vn = __shfl_xor(v, 1);
            if ((r32 & 1) == 0) *(unsigned*)(Ow + (unsigned)orow * ostrb + d0 * 64) = cvtpk(v, vn); } }
    __syncthreads();
#undef RESC
#undef KBASE
#undef ACT
#undef MASKT
#undef SEAM_K0
#undef HALF_STEP
}
#undef ROW
#undef VMW
#undef VMWN
#undef SLOAD_H
#undef SWRITE_HK
#undef SWRITE_HV
#undef SWRITE_H
#undef LD8
#undef QROWP

struct Tensors { const bf16_t* Q; const bf16_t* K; const bf16_t* V; bf16_t* O; float* LSE; const float* lut; const float* gq; };
__device__ __forceinline__ BlockRef unit_ref(const Tensors& T, int u, int dl) {
    const int nqbl = 4 - dl, qb = u & ((1 << nqbl) - 1), t = u >> nqbl, r = t & ((1 << dl) - 1), bh = t >> dl, b = bh >> 3, h = bh & 7;
    const size_t base = ((size_t)bh * 4096 + ((size_t)r << (12 - dl))) * D;
    const size_t tok = (size_t)b * 4096 + ((size_t)(qb * QB) << dl) + r;
    BlockRef R; R.Q = T.Q + base + (size_t)qb * QB * D; R.K = T.K + base; R.V = T.V + base; R.O = T.O + tok * 1024 + h * D; R.LSE = T.LSE + tok * 8 + h; R.P0 = qb * QB; R.lut = h * LUTW * 4;
    return R;
}
__device__ __forceinline__ void attn_phase(lptr lds, const Tensors& T, int dl, int vcu, int G, int wave) {
    constexpr int NU = 512;
    const int tid = fresh_tid(wave);
    const int per = (NU + G - 1) / G, u0 = vcu * per, u1 = (u0 + per < NU) ? u0 + per : NU;
    ATT_LAS float* lut = (ATT_LAS float*)(lds + LDS_LUT);
    for (int i = tid; i < 8 * LUTW; i += NW * 64) lut[i] = T.lut[i];
    if (u0 >= u1) { __syncthreads(); return; }
    PhaseConst pc; pc.skv = 4096 >> dl; pc.ostr = 1024 << dl; pc.lstr = 8 << dl; pc.gq = T.gq;
    Seam S;
    BlockRef cur = unit_ref(T, u0, dl);
    swa_prime(cur, lds, S, tid);
    for (int u = u0; u < u1; ++u) {
        const bool last = (u + 1 >= u1);
        const BlockRef nxt = last ? cur : unit_ref(T, u + 1, dl);
        swa_block(cur, nxt, pc, lds, S, tid);
        cur = nxt;
    }
}
#undef KSWZ
#undef SBAR
}

constexpr int NWAVES = 8;
constexpr int NB = 4, SEQ = 4096, D = 1024, M = NB * SEQ, NH = 8, HD = 128, NG = 3, FF = 2816, NUP = 2 * FF;
constexpr float RMS_EPS = 1e-6f, ATT_SCALE = 0.08838834764831845f;
constexpr size_t MiB = 1u << 20;
constexpr size_t WS_CTL = 0, CTL_ZERO_BYTES = 1 * MiB;
constexpr size_t WS_MOD = 1 * MiB;
constexpr size_t WS_LBS = 1 * MiB + 256 * 1024;
constexpr size_t WS_LUT = 1 * MiB + 320 * 1024;
constexpr size_t WS_ML = 2 * MiB;
constexpr size_t WS_LUT2 = 1 * MiB + 384 * 1024;
constexpr size_t WS_GQ = 1 * MiB + 448 * 1024;
constexpr size_t WS_WQKV = 8 * MiB, WS_WO = 26 * MiB, WS_W13_0 = 28 * MiB, WS_W2_0 = 39 * MiB;
constexpr size_t WS_WIN = 44 * MiB + 512 * 1024, WS_WHO = WS_WIN + 8 * MiB, WS_W13_1 = WS_WHO + 2 * MiB, WS_W2_1 = WS_W13_1 + 11 * MiB;
constexpr size_t WS_SG = 8 * MiB;
constexpr size_t WS_ACT = 72 * MiB;
constexpr size_t WS_BIG = 104 * MiB;
constexpr size_t WS_R2 = 200 * MiB;
constexpr size_t WS_END = 256 * MiB;
constexpr size_t QKV_STRIDE = (size_t)NB * NH * SEQ * HD;
constexpr int LUT_N = 129;
constexpr int CW_BAR = 4096;
constexpr int RING_BYTES = 131072, LDSCTL_OFF = RING_BYTES, MISC_OFF = LDSCTL_OFF + 320, LDS_BYTES = 147456;

struct Args { const float* in[18]; float* out; unsigned char* ws; int ph_lo, ph_hi; };
struct Frame {
    LAS unsigned char* lds; volatile LAS unsigned* MISC; gu32* ctl;
    int wave, vcu, G;
};

typedef const __attribute__((address_space(4))) Args* kargs_t;
__device__ __forceinline__ kargs_t kargs() { kargs_t p = (kargs_t)__builtin_amdgcn_kernarg_segment_ptr(); asm volatile("" : "+s"(p)); return p; }
__device__ __forceinline__ float bf2f(unsigned short h) { return __builtin_bit_cast(float, (unsigned)h << 16); }
__device__ __forceinline__ float bflo(unsigned w) { return __builtin_bit_cast(float, w << 16); }
__device__ __forceinline__ float bfhi(unsigned w) { return __builtin_bit_cast(float, w & 0xffff0000u); }
__device__ __forceinline__ float wave_sum(float v) {
#pragma unroll
    for (int o = 1; o < 64; o <<= 1) v += __shfl_xor(v, o);
    return v;
}
__device__ __forceinline__ void tr_item(const float* W, int Nsrc, int K, bf16* WT, int k0, int n0s, int drow0, LAS float* scr, int lane) {
#pragma unroll 8
    for (int i = 0; i < 32; ++i) { const int kk = 2 * i + (lane >> 5); scr[kk * 33 + (lane & 31)] = W[(size_t)(k0 + kk) * Nsrc + n0s + (lane & 31)]; }
    LDS_WAIT(); asm volatile("" ::: "memory");
    const int c = lane & 7;
#pragma unroll
    for (int j = 0; j < 4; ++j) { const int n = (lane >> 3) + 8 * j; const LAS float* s = scr + (8 * c) * 33 + n;
        v4u o; o.x = pk2(s[0 * 33], s[1 * 33]); o.y = pk2(s[2 * 33], s[3 * 33]); o.z = pk2(s[4 * 33], s[5 * 33]); o.w = pk2(s[6 * 33], s[7 * 33]);
        *(GAS v4u*)(WT + (size_t)(drow0 + n) * K + k0 + 8 * c) = o; }
    LDS_WAIT(); asm volatile("" ::: "memory");
}
__device__ __forceinline__ int t5_bucket(int n) {
    if (n < 16) return n;
    int v = 16 + (int)(log((double)n / 16.0) / log(128.0) * 16.0);
    return v > 31 ? 31 : v;
}
__device__ __forceinline__ void p0_prologue(Frame& F) {
    const int ptid = fresh_tid(F.wave), plane = ptid & 63;
    const kargs_t A = kargs(); unsigned char* const ws = A->ws;
    if (F.vcu < 48) {
        LAS float* cact = (LAS float*)F.lds;
        LAS float* red = (LAS float*)(F.lds + 16384);
        for (int i = ptid; i < 4096; i += NWAVES * 64) { const float c = A->in[1][i]; cact[i] = c * __builtin_amdgcn_rcpf(1.0f + __expf(-c)); }
        __syncthreads();
        const int l = F.vcu / 24, cg = F.vcu % 24;
        const float* wp = A->in[3] + (size_t)l * 1024 * 6144 + (size_t)(F.wave * 128) * 6144 + cg * 256 + plane * 4;
        f32x4 a0 = {0.f, 0.f, 0.f, 0.f}, a1 = a0, a2 = a0, a3 = a0;
#pragma unroll 8
        for (int k = 0; k < 128; ++k) { const f32x4 wv = *(const f32x4*)(wp + (size_t)k * 6144); const int kk = F.wave * 128 + k;
            a0 += wv * cact[kk]; a1 += wv * cact[1024 + kk]; a2 += wv * cact[2048 + kk]; a3 += wv * cact[3072 + kk]; }
        LAS f32x4* r4 = (LAS f32x4*)red + F.wave * 256;
        r4[plane] = a0; r4[64 + plane] = a1; r4[128 + plane] = a2; r4[192 + plane] = a3;
        __syncthreads();
        float* mod = (float*)(ws + WS_MOD);
        for (int idx = ptid; idx < 1024; idx += NWAVES * 64) { const int b = idx >> 8, col = idx & 255; float s = 0.f;
#pragma unroll
            for (int w = 0; w < 8; ++w) s += red[(w * 4 + b) * 256 + col];
            mod[(size_t)(l * 4 + b) * 6144 + cg * 256 + col] = s + A->in[4][l * 6144 + cg * 256 + col]; }
        __syncthreads();
    } else if (F.vcu == 48) {
        float* lbs = (float*)(ws + WS_LBS);
        for (int k = ptid; k < 1024; k += NWAVES * 64) { const float b0 = A->in[14][k], b1 = A->in[14][1024 + k]; lbs[k] = 1.0f / (1.0f + expf(b0 - b1)); }
    } else if (F.vcu == 49) {
        float* lut = (float*)(ws + WS_LUT);
        for (int i = ptid; i < NG * NH * LUT_N; i += NWAVES * 64) { const int j = i % LUT_N, gh = i / LUT_N, g = gh >> 3;
            lut[i] = A->in[2][t5_bucket(j << (2 * g)) * (NG * NH) + gh]; }
        float* lut2 = (float*)(ws + WS_LUT2);
        for (int i = ptid; i < NG * NH * att::LUTW; i += NWAVES * 64) { const int j = i % att::LUTW - att::LUT_OFF, gh = i / att::LUTW, g = gh >> 3;
            lut2[i] = (j >= 0 && j <= 128) ? A->in[2][t5_bucket(j << (2 * g)) * (NG * NH) + gh] * (1.0f / ATT_SCALE) : 0.f; }
        float* gq = (float*)(ws + WS_GQ);
        for (int i = ptid; i < NG * 128; i += NWAVES * 64) gq[i] = A->in[9][i] * A->in[10][i];
    }
    LAS float* scr = (LAS float*)(F.lds + F.wave * 16384);
    const int gw = F.vcu * NWAVES + F.wave, NGW = F.G * NWAVES;
    constexpr int I_QKV = 16 * 288, I_SQ = 16 * 32, I_UP = 16 * 88, I_DN = 44 * 32, I_IN = 16 * 128;
    constexpr int NITEMS = I_QKV + I_SQ + 2 * I_UP + I_DN + I_IN + I_SQ + 2 * I_UP + I_DN;
    for (int it = gw; it < NITEMS; it += NGW) {
        int r = it;
        if (r < I_QKV) { const int kb = r / 288, nb = r % 288; tr_item(A->in[7], 9216, 1024, (bf16*)(ws + WS_WQKV), 64 * kb, 32 * nb, 32 * nb, scr, plane); continue; } r -= I_QKV;
        if (r < I_SQ) { const int kb = r / 32, nb = r % 32; tr_item(A->in[8], 1024, 1024, (bf16*)(ws + WS_WO), 64 * kb, 32 * nb, 32 * nb, scr, plane); continue; } r -= I_SQ;
        if (r < I_IN) { const int kb = r / 128, nb = r % 128;
            const int seg = nb >> 5, hh = (nb >> 2) & 7, sub = nb & 3;
            tr_item(A->in[11], 4096, 1024, (bf16*)(ws + WS_WIN), 64 * kb, 32 * nb, 256 * (2 * hh + (seg >> 1)) + 128 * (seg & 1) + 32 * sub, scr, plane); continue; } r -= I_IN;
        if (r < I_SQ) { const int kb = r / 32, nb = r % 32; tr_item(A->in[12], 1024, 1024, (bf16*)(ws + WS_WHO), 64 * kb, 32 * nb, 32 * nb, scr, plane); continue; } r -= I_SQ;
        const int l = r / (2 * I_UP + I_DN); r -= l * (2 * I_UP + I_DN);
        if (r < 2 * I_UP) { const int which = r / I_UP, rr = r % I_UP, kb = rr / 88, nb = rr % 88;
            tr_item((which ? A->in[16] : A->in[15]) + (size_t)l * 1024 * FF, FF, 1024, (bf16*)(ws + (l ? WS_W13_1 : WS_W13_0)), 64 * kb, 32 * nb, 256 * (nb >> 2) + 128 * which + 32 * (nb & 3), scr, plane); continue; } r -= 2 * I_UP;
        { const int kb = r / 32, nb = r % 32; tr_item(A->in[17] + (size_t)l * FF * 1024, 1024, FF, (bf16*)(ws + (l ? WS_W2_1 : WS_W2_0)), 64 * kb, 32 * nb, 32 * nb, scr, plane); }
    }
}
__device__ __forceinline__ void norm_mod_pass(Frame& F, const float* x, const float* gain, const float* sh, const float* sc) {
    const int ptid = fresh_tid(F.wave), plane = ptid & 63;
    unsigned char* const ws = kargs()->ws;
    const int gw = F.vcu * NWAVES + F.wave, NGW = F.G * NWAVES;
    bf16* act = (bf16*)(ws + WS_ACT);
    for (int r0 = gw * 8; r0 < M; r0 += NGW * 8) {
        const int b = r0 >> 12;
        f32x4 gam[4], shv[4];
#pragma unroll
        for (int j = 0; j < 4; ++j) { const int c = 4 * plane + 256 * j; const f32x4 gn = *(const f32x4*)(gain + c), s = *(const f32x4*)(sc + b * 6144 + c);
            gam[j] = gn * (s + 1.0f); shv[j] = *(const f32x4*)(sh + b * 6144 + c); }
#pragma unroll 1
        for (int rr = 0; rr < 8; rr += 2) {
            f32x4 v[2][4];
#pragma unroll
            for (int q = 0; q < 2; ++q)
#pragma unroll
                for (int j = 0; j < 4; ++j) v[q][j] = *(const GAS f32x4*)(x + (size_t)(r0 + rr + q) * D + 4 * plane + 256 * j);
#pragma unroll
            for (int q = 0; q < 2; ++q) { float s = 0.f;
#pragma unroll
                for (int j = 0; j < 4; ++j) s += (v[q][j].x * v[q][j].x + v[q][j].y * v[q][j].y) + (v[q][j].z * v[q][j].z + v[q][j].w * v[q][j].w);
                const float rstd = 1.0f / sqrtf(wave_sum(s) * (1.0f / D) + RMS_EPS);
                GAS unsigned long long* o8 = (GAS unsigned long long*)(act + (size_t)(r0 + rr + q) * D) + plane;
#pragma unroll
                for (int j = 0; j < 4; ++j) { const f32x4 o = v[q][j] * rstd * gam[j] + shv[j];
                    o8[64 * j] = (unsigned long long)pk2(o.x, o.y) | ((unsigned long long)pk2(o.z, o.w) << 32); } }
        }
    }
}
__device__ __forceinline__ void attn_naive(Frame& F, int g) {
    const int ptid = fresh_tid(F.wave), plane = ptid & 63;
    const kargs_t A = kargs(); unsigned char* const ws = A->ws; float* const outp = A->out;
    const int dl = 2 * g, dmask = (1 << dl) - 1, Lsub = SEQ >> dl;
    const bf16* Q = (const bf16*)(ws + WS_BIG); const bf16* K = Q + QKV_STRIDE; const bf16* V = K + QKV_STRIDE;
    float* ML = (float*)(ws + WS_ML); float* orun = outp; bf16* act = (bf16*)(ws + WS_ACT);
    const float* lut = (const float*)(ws + WS_LUT);
    const int l2 = 2 * plane;
    const float qk0 = A->in[9][g * 128 + l2] * A->in[10][g * 128 + l2], qk1 = A->in[9][g * 128 + l2 + 1] * A->in[10][g * 128 + l2 + 1];
    const int gw = F.vcu * NWAVES + F.wave, NGW = F.G * NWAVES;
    for (int item = gw; item < M * NH; item += NGW) {
        const int row = item >> 3, h = item & 7, b = row >> 12, t = row & 4095, r = t & dmask, mi = t >> dl;
        const size_t hb = ((size_t)(b * 8 + h) * SEQ + (size_t)r * Lsub) * HD;
        const unsigned qw = *(const GAS unsigned*)(Q + hb + (size_t)mi * HD + l2);
        float q0 = bflo(qw), q1 = bfhi(qw);
        const float rq = 1.0f / sqrtf(wave_sum(q0 * q0 + q1 * q1) * (1.0f / HD) + RMS_EPS);
        q0 *= rq * qk0; q1 *= rq * qk1;
        float m = -1e30f, l = 0.f, o0 = 0.f, o1 = 0.f;
        if (g > 0) { m = ML[(size_t)item * 2]; l = ML[(size_t)item * 2 + 1]; o0 = orun[(size_t)row * D + h * HD + l2]; o1 = orun[(size_t)row * D + h * HD + l2 + 1]; }
        const float* bl = lut + (g * 8 + h) * LUT_N;
        const int nj = mi < 128 ? mi : 128;
        for (int j = 0; j <= nj; ++j) {
            const size_t ko = hb + (size_t)(mi - j) * HD + l2;
            const unsigned kw = *(const GAS unsigned*)(K + ko), vw = *(const GAS unsigned*)(V + ko);
            const float k0 = bflo(kw), k1 = bfhi(kw);
            float a = q0 * k0 + q1 * k1, s2 = k0 * k0 + k1 * k1;
#pragma unroll
            for (int o = 1; o < 64; o <<= 1) { a += __shfl_xor(a, o); s2 += __shfl_xor(s2, o); }
            const float s = a * (1.0f / sqrtf(s2 * (1.0f / HD) + RMS_EPS)) * ATT_SCALE + bl[j];
            const float mn = fmaxf(m, s), al = __expf(m - mn), p = __expf(s - mn);
            l = l * al + p; o0 = o0 * al + p * bflo(vw); o1 = o1 * al + p * bfhi(vw); m = mn;
        }
        if (g < 2) { if (plane == 0) { ML[(size_t)item * 2] = m; ML[(size_t)item * 2 + 1] = l; }
            orun[(size_t)row * D + h * HD + l2] = o0; orun[(size_t)row * D + h * HD + l2 + 1] = o1; }
        else { const float il = 1.0f / l; *(GAS unsigned*)(act + (size_t)row * D + h * HD + l2) = pk2(o0 * il, o1 * il); }
    }
}
__device__ __forceinline__ void merge_pass(Frame& F) {
    const int ptid = fresh_tid(F.wave), plane = ptid & 63;
    const kargs_t A = kargs(); unsigned char* const ws = A->ws;
    const bf16* O0 = (const bf16*)A->out; const bf16* O1 = O0 + (size_t)M * D; const bf16* O2 = (const bf16*)(ws + WS_R2);
    const float* L = (const float*)(ws + WS_ML); bf16* act = (bf16*)(ws + WS_ACT);
    const int gw = F.vcu * NWAVES + F.wave, NGW = F.G * NWAVES, head = plane >> 3;
    for (int r0 = gw * 8; r0 < M; r0 += NGW * 8) {
#pragma unroll 2
        for (int rr = 0; rr < 8; ++rr) { const size_t row = (size_t)(r0 + rr), off = row * D + 16 * plane;
            const float l0 = L[row * 8 + head], l1 = L[(size_t)M * 8 + row * 8 + head], l2 = L[(size_t)2 * M * 8 + row * 8 + head];
            const v4u a0 = *(const GAS v4u*)(O0 + off), a1 = *(const GAS v4u*)(O0 + off + 8), b0 = *(const GAS v4u*)(O1 + off), b1 = *(const GAS v4u*)(O1 + off + 8), c0 = *(const GAS v4u*)(O2 + off), c1 = *(const GAS v4u*)(O2 + off + 8);
            const float mx = fmaxf(l0, fmaxf(l1, l2));
            float w0 = __builtin_amdgcn_exp2f(l0 - mx), w1 = __builtin_amdgcn_exp2f(l1 - mx), w2 = __builtin_amdgcn_exp2f(l2 - mx);
            const float inv = 1.0f / (w0 + w1 + w2); w0 *= inv; w1 *= inv; w2 *= inv;
            v4u o0, o1;
#pragma unroll
            for (int i = 0; i < 4; ++i) {
                o0[i] = pk2(w0 * bflo(a0[i]) + w1 * bflo(b0[i]) + w2 * bflo(c0[i]), w0 * bfhi(a0[i]) + w1 * bfhi(b0[i]) + w2 * bfhi(c0[i]));
                o1[i] = pk2(w0 * bflo(a1[i]) + w1 * bflo(b1[i]) + w2 * bflo(c1[i]), w0 * bfhi(a1[i]) + w1 * bfhi(b1[i]) + w2 * bfhi(c1[i])); }
            *(GAS v4u*)(act + off) = o0; *(GAS v4u*)(act + off + 8) = o1; }
    }
}
__device__ __forceinline__ void hgrn_naive(Frame& F) {
    const int ptid = fresh_tid(F.wave), plane = ptid & 63;
    if (F.vcu >= NB * NH) return;
    const kargs_t A = kargs(); unsigned char* const ws = A->ws;
    const int b = F.vcu >> 3, h = F.vcu & 7, kq = F.wave >> 1, v = 64 * (F.wave & 1) + plane;
    const bf16* QS = (const bf16*)(ws + WS_BIG); const float* FG = (const float*)(ws + WS_BIG + 32 * MiB);
    const bf16* V = (const bf16*)(ws + WS_R2); const bf16* SG = (const bf16*)(ws + WS_SG); bf16* act = (bf16*)(ws + WS_ACT);
    LAS float* po = (LAS float*)F.lds;
    float S[32];
#pragma unroll
    for (int j = 0; j < 32; ++j) S[j] = 0.f;
    const int tt2 = ptid >> 5, l32 = ptid & 31;
    const f32x4 gn = *(const f32x4*)(A->in[13] + 4 * l32);
    for (int t0 = 0; t0 < SEQ; t0 += 16) {
        for (int tt = 0; tt < 16; ++tt) {
            const size_t ro = (size_t)(b * SEQ + t0 + tt) * D + h * HD;
            const float iv = bf2f(V[ro + v]);
            const float* fgp = FG + ro + 32 * kq; const bf16* qp = QS + ro + 32 * kq;
            float acc = 0.f;
#pragma unroll
            for (int j4 = 0; j4 < 8; ++j4) { const f32x4 f4 = *(const f32x4*)(fgp + 4 * j4); const unsigned long long q4 = *(const unsigned long long*)(qp + 4 * j4);
#pragma unroll
                for (int i = 0; i < 4; ++i) { const float fg = f4[i], qv = bf2f((unsigned short)(q4 >> (16 * i)));
                    S[4 * j4 + i] = fg * S[4 * j4 + i] + (1.0f - fg) * iv; acc += qv * S[4 * j4 + i]; } }
            po[(tt * 4 + kq) * 128 + v] = acc;
        }
        __syncthreads();
        { const size_t ro = (size_t)(b * SEQ + t0 + tt2) * D + h * HD + 4 * l32;
          const LAS f32x4* p4 = (const LAS f32x4*)po + (tt2 * 4) * 32 + l32;
          const f32x4 o = (p4[0] + p4[32]) + (p4[64] + p4[96]);
          float ss = (o.x * o.x + o.y * o.y) + (o.z * o.z + o.w * o.w);
#pragma unroll
          for (int sft = 1; sft < 32; sft <<= 1) ss += __shfl_xor(ss, sft);
          const float rstd = 1.0f / sqrtf(ss * (1.0f / HD) + RMS_EPS);
          const unsigned long long sg = *(const unsigned long long*)(SG + ro);
          const f32x4 r = o * rstd * gn;
          const unsigned lo = pk2(r.x * bf2f((unsigned short)sg), r.y * bf2f((unsigned short)(sg >> 16))), hi = pk2(r.z * bf2f((unsigned short)(sg >> 32)), r.w * bf2f((unsigned short)(sg >> 48)));
          *(GAS unsigned long long*)(act + ro) = (unsigned long long)lo | ((unsigned long long)hi << 32); }
        __syncthreads();
    }
}

constexpr int NPHASE = 20;
#ifndef NAIVE_ATTN
#define NAIVE_ATTN 0
#endif
__global__ void __launch_bounds__(NWAVES * 64, 2) mk_fwd(Args args) {
    extern __shared__ __attribute__((aligned(16))) unsigned char lds[];
    Frame F;
    F.lds = (LAS unsigned char*)lds; F.MISC = (volatile LAS unsigned*)(F.lds + MISC_OFF);
    F.wave = __builtin_amdgcn_readfirstlane((int)threadIdx.x >> 6);
    F.G = gridDim.x; { const int bx = blockIdx.x; F.vcu = (F.G % 8 == 0) ? (bx % 8) * (F.G / 8) + bx / 8 : bx; }
    F.ctl = (gu32*)(args.ws + WS_CTL);
    for (int u = fresh_tid(F.wave); u < (LDS_BYTES - LDSCTL_OFF) / 4; u += NWAVES * 64) ((LAS unsigned*)(F.lds + LDSCTL_OFF))[u] = 0u;
    __syncthreads();
    const int lo = args.ph_lo, hi = args.ph_hi;
    const bool multi = (hi - lo) > 1;
    XcdBarrier bar; bar.bar = (unsigned*)(F.ctl + CW_BAR); bar.x = 0; bar.st = nullptr; bar.wave = F.wave;
    if (multi) bar = xcd_barrier_post((unsigned*)(F.ctl + CW_BAR), F.MISC + 8, F.wave);
#ifndef PH_MASK
#define PH_MASK 0xFFFFFFFFu
#endif
#define IN(k) (((PH_MASK >> (k)) & 1u) && lo <= (k) && (k) < hi)
#define SEAM(k) do { if (IN(k) && IN((k) + 1)) xcd_barrier(bar); } while (0)
#define PHASE_PTRS const kargs_t A = kargs(); unsigned char* const ws = A->ws; float* const outp = A->out; float* const mod = (float*)(ws + WS_MOD); bf16* const act = (bf16*)(ws + WS_ACT); (void)outp; (void)mod; (void)act
    enum { P_PRO = 0, P_XN0 = 1, P_QKV = 2  , P_ATT = 3  , P_MRG = 8, P_WO = 9, P_XNF0 = 10, P_UP0 = 11, P_DN0 = 12, P_XN1 = 13, P_HIN = 14, P_SCAN = 15, P_HOUT = 16, P_XNF1 = 17, P_UP1 = 18, P_DN1 = 19 };
    if (IN(P_PRO)) { p0_prologue(F); } SEAM(P_PRO);
    if (IN(P_XN0)) { PHASE_PTRS; norm_mod_pass(F, A->in[0], A->in[5], mod + 0, mod + 1024); } SEAM(P_XN0);
#if NAIVE_ATTN
#define ATT_GROUP(g) if (IN(P_ATT + 2 * (g))) { attn_naive(F, (g)); } SEAM(P_ATT + 2 * (g));
#else
#define ATT_GROUP(g) if (IN(P_ATT + 2 * (g))) { PHASE_PTRS; \
            att::Tensors T; T.Q = (const bf16*)(ws + WS_BIG); T.K = T.Q + QKV_STRIDE; T.V = T.K + QKV_STRIDE; \
            T.O = (g) == 2 ? (bf16*)(ws + WS_R2) : (bf16*)outp + (size_t)(g) * M * D; T.LSE = (float*)(ws + WS_ML) + (size_t)(g) * M * 8; \
            T.lut = (const float*)(ws + WS_LUT2) + (g) * 8 * att::LUTW; T.gq = (const float*)(ws + WS_GQ) + (g) * 128; \
            att::attn_phase((att::lptr)F.lds, T, 2 * (g), F.vcu, F.G, F.wave); \
        } SEAM(P_ATT + 2 * (g));
#endif
#define QKV_GROUP(g) if (IN(P_QKV + 2 * (g))) { PHASE_PTRS; \
            pg8::Gemm gm{act, (const bf16*)(ws + WS_WQKV) + (size_t)(g) * 3072 * 1024, M, 3072, 1024}; pg8::StaticOrder S; S.init(M, 3072, F.G, (int)blockIdx.x); \
            pg8::EpiQKV E{(bf16*)(ws + WS_BIG), 2 * (g)}; \
            pg8::gemm_phase<pg8::EpiQKV, pg8::StaticOrder, true, true>(F.lds, gm, S, E, F.wave); \
        } SEAM(P_QKV + 2 * (g));
    QKV_GROUP(0) ATT_GROUP(0) QKV_GROUP(1) ATT_GROUP(1) QKV_GROUP(2) ATT_GROUP(2)
#if !NAIVE_ATTN
    if (IN(P_MRG)) { merge_pass(F); }
#endif
    SEAM(P_MRG);
    if (IN(P_WO)) { PHASE_PTRS;
        pg8::Gemm gm{act, (const bf16*)(ws + WS_WO), M, 1024, 1024}; pg8::StaticOrder S; S.init(M, 1024, F.G, (int)blockIdx.x);
        pg8::EpiRes E{A->in[0], outp, mod + 2048};
        pg8::gemm_phase<pg8::EpiRes, pg8::StaticOrder, true, true>(F.lds, gm, S, E, F.wave);
    } SEAM(P_WO);
#define FFN_LAYER(l, p0) \
        if (IN(p0)) { PHASE_PTRS; float* const modl = mod + (size_t)(l) * 4 * 6144; norm_mod_pass(F, outp, A->in[6] + (l) * 1024, modl + 3072, modl + 4096); } SEAM(p0); \
        if (IN((p0) + 1)) { PHASE_PTRS; \
            pg8::Gemm gm{act, (const bf16*)(ws + ((l) ? WS_W13_1 : WS_W13_0)), M, NUP, 1024}; pg8::StaticOrder S; S.init(M, NUP, F.G, (int)blockIdx.x); \
            pg8::EpiSwiGLU E{(bf16*)(ws + WS_BIG), FF}; \
            pg8::gemm_phase<pg8::EpiSwiGLU, pg8::StaticOrder, true, true>(F.lds, gm, S, E, F.wave); \
        } SEAM((p0) + 1); \
        if (IN((p0) + 2)) { PHASE_PTRS; float* const modl = mod + (size_t)(l) * 4 * 6144; \
            pg8::Gemm gm{(const bf16*)(ws + WS_BIG), (const bf16*)(ws + ((l) ? WS_W2_1 : WS_W2_0)), M, 1024, FF}; pg8::StaticOrder S; S.init(M, 1024, F.G, (int)blockIdx.x); \
            pg8::EpiRes E{outp, outp, modl + 5120}; \
            pg8::gemm_phase<pg8::EpiRes, pg8::StaticOrder, true, true>(F.lds, gm, S, E, F.wave); \
        } SEAM((p0) + 2);
    FFN_LAYER(0, P_XNF0)
    if (IN(P_XN1)) { PHASE_PTRS; float* const mod1 = mod + (size_t)4 * 6144; norm_mod_pass(F, outp, A->in[5] + 1024, mod1 + 0, mod1 + 1024); } SEAM(P_XN1);
    if (IN(P_HIN)) { PHASE_PTRS;
        pg8::Gemm gm{act, (const bf16*)(ws + WS_WIN), M, 4096, 1024}; pg8::StaticOrder S; S.init(M, 4096, F.G, (int)blockIdx.x);
        pg8::EpiHgrnNaive E{(bf16*)(ws + WS_BIG), (float*)(ws + WS_BIG + 32 * MiB), (bf16*)(ws + WS_R2), (bf16*)(ws + WS_SG), (const float*)(ws + WS_LBS)};
        pg8::gemm_phase<pg8::EpiHgrnNaive, pg8::StaticOrder, true, true>(F.lds, gm, S, E, F.wave);
    } SEAM(P_HIN);
    if (IN(P_SCAN)) { hgrn_naive(F); } SEAM(P_SCAN);
    if (IN(P_HOUT)) { PHASE_PTRS; float* const mod1 = mod + (size_t)4 * 6144;
        pg8::Gemm gm{act, (const bf16*)(ws + WS_WHO), M, 1024, 1024}; pg8::StaticOrder S; S.init(M, 1024, F.G, (int)blockIdx.x);
        pg8::EpiRes E{outp, outp, mod1 + 2048};
        pg8::gemm_phase<pg8::EpiRes, pg8::StaticOrder, true, true>(F.lds, gm, S, E, F.wave);
    } SEAM(P_HOUT);
    FFN_LAYER(1, P_XNF1)
#undef IN
#undef SEAM
}

#ifndef MK_PER_PHASE
#define MK_PER_PHASE 0
#endif
extern "C" void kernel_launch(void* const* d_in, const int* in_sizes, int n_in, void* d_out, int out_size, void* d_ws, size_t ws_size, hipStream_t stream) {
    static int grid = 0;
    if (grid == 0) {
        if (n_in != 18 || in_sizes[0] != M * D || out_size != M * D || ws_size < WS_END) { fprintf(stderr, "kernel_launch: unexpected shapes (n_in %d, in0 %d, out %d, ws %zu); nothing launched\n", n_in, n_in > 0 ? in_sizes[0] : -1, out_size, ws_size); grid = -1; return; }
        int dev = 0, cus = 0, per_cu = 0;
        if (hipGetDevice(&dev) != hipSuccess || hipDeviceGetAttribute(&cus, hipDeviceAttributeMultiprocessorCount, dev) != hipSuccess) { grid = -1; return; }
        if (hipFuncSetAttribute((const void*)mk_fwd, hipFuncAttributeMaxDynamicSharedMemorySize, LDS_BYTES) != hipSuccess) { fprintf(stderr, "kernel_launch: hipFuncSetAttribute failed\n"); grid = -1; return; }
        if (hipOccupancyMaxActiveBlocksPerMultiprocessor(&per_cu, (const void*)mk_fwd, NWAVES * 64, LDS_BYTES) != hipSuccess || per_cu < 1) { fprintf(stderr, "kernel_launch: occupancy query says %d blocks per CU\n", per_cu); (void)hipGetLastError(); grid = -1; return; }
        grid = cus;
    }
    if (grid < 0) return;
    if (hipMemsetAsync((char*)d_ws + WS_CTL, 0, CTL_ZERO_BYTES, stream) != hipSuccess) return;
    Args a{};
    for (int i = 0; i < 18; ++i) a.in[i] = (const float*)d_in[i];
    a.out = (float*)d_out; a.ws = (unsigned char*)d_ws;
#if MK_PER_PHASE
    for (int p = 0; p < NPHASE; ++p) { a.ph_lo = p; a.ph_hi = p + 1; hipLaunchKernelGGL(mk_fwd, dim3(grid), dim3(NWAVES * 64), LDS_BYTES, stream, a); }
#else
    a.ph_lo = 0; a.ph_hi = NPHASE; hipLaunchKernelGGL(mk_fwd, dim3(grid), dim3(NWAVES * 64), LDS_BYTES, stream, a);
#endif
}
```

```cpp
#include <hip/hip_runtime.h>
#include <cstdio>
#include <cstdint>
#include <cmath>

__device__ __forceinline__ int fresh_lane() { unsigned z = 0u; asm volatile("" : "+s"(z)); return (int)__builtin_amdgcn_mbcnt_hi(~0u, __builtin_amdgcn_mbcnt_lo(~0u, z)); }
__device__ __forceinline__ int fresh_tid(int wave) { return wave * 64 + fresh_lane(); }

namespace pg8 {
#define PG8_LAS __attribute__((address_space(3)))
typedef unsigned short bf16_t;
typedef short bf16x8 __attribute__((ext_vector_type(8)));
typedef float f32x4 __attribute__((ext_vector_type(4)));
typedef unsigned u32x4 __attribute__((ext_vector_type(4)));
constexpr int BM = 256, BK = 64, HALF = 128, HTB = HALF * BK * 2  , STAGE_BYTES = 8 * HTB, NXCD = 8, WGM = 8;

__host__ __device__ __forceinline__ int lds_byte(int r, int c) { const int st = (r >> 4) * 2 + (c >> 5), rr = r & 15, cc = c & 31, ob = rr * 64 + cc * 2; return st * 1024 + (ob ^ (((ob >> 9) & 1) << 5)); }
__host__ __device__ __forceinline__ void stage_rc(int b, int& R, int& C) { const int st = b / 1024, sb = b % 1024, swz = sb ^ (((sb >> 9) & 1) << 5); R = (st >> 1) * 16 + swz / 64; C = (st & 1) * 32 + (swz % 64) / 2; }
__host__ __device__ __forceinline__ int perm32(int rho) { const int n = rho >> 4, i = rho & 15; return 8 * (i >> 2) + 4 * n + (i & 3); }

struct Unit { int pm, pn; };
struct Gemm { const bf16_t* A; const bf16_t* Bt; int M, N, K; };

struct StaticOrder {
    int nM, nN, nwg, G, c;
    __host__ __device__ void init(int M, int N, int G_, int c_) { nM = M / BM; nN = N / BM; nwg = nM * nN; G = G_; c = c_; }
    __host__ __device__ bool next(int i, Unit& u) const {
        const long L = (long)i * G + c; if (L >= nwg) return false;
        int wgid = (int)L; { const int q = nwg / NXCD, r = nwg % NXCD, xcd = wgid % NXCD, off = wgid / NXCD; wgid = (xcd < r ? xcd * (q + 1) : r * (q + 1) + (xcd - r) * q) + off; }
        const int nig = WGM * nN, gid = wgid / nig, fm = gid * WGM, gsz = (nM - fm) < WGM ? (nM - fm) : WGM;
        u.pm = fm + ((wgid % nig) % gsz); u.pn = (wgid % nig) / gsz; return true;
    }
    __device__ __forceinline__ void a_ready(const Unit&) const {}
    __device__ __forceinline__ void done(const Unit&) const {}
};


__device__ __forceinline__ unsigned cvt_pk_bf16(float lo, float hi) { unsigned r; asm volatile("v_cvt_pk_bf16_f32 %0, %1, %2" : "=v"(r) : "v"(lo), "v"(hi)); return r; }
__device__ __forceinline__ float silu_f(float a) { return a * __builtin_amdgcn_rcpf(1.0f + __expf(-a)); }
__device__ __forceinline__ float sigmoid_f(float a) { return __builtin_amdgcn_rcpf(1.0f + __expf(-a)); }
__device__ __forceinline__ u32x4 pack8(const f32x4 a, const f32x4 b) { u32x4 w; w.x = cvt_pk_bf16(a[0], a[1]); w.y = cvt_pk_bf16(a[2], a[3]); w.z = cvt_pk_bf16(b[0], b[1]); w.w = cvt_pk_bf16(b[2], b[3]); return w; }

struct EpiQKV {
    static constexpr bool PERM = true, AFTER_DRAIN = false;
    bf16_t* base; int dl;
    __device__ __forceinline__ void operator()(const f32x4 (&acc)[2][2][4][2], const Unit& u, int wr, int wc, int fr, int fq) const {
        const int which = u.pn >> 2, h0 = (u.pn & 3) * 2, dcol = wc * 32 + 8 * fq;
        bf16_t* ob = base + (size_t)which * (size_t)(4 * 8 * 4096 * 128);
        const int row0 = u.pm * BM + wr * 64 + fr;
#pragma unroll
        for (int ai = 0; ai < 2; ++ai)
#pragma unroll
            for (int m = 0; m < 4; ++m) { const int row = row0 + ai * HALF + m * 16, b = row >> 12, t = row & 4095;
                const int sp = ((t & ((1 << dl) - 1)) << (12 - dl)) + (t >> dl);
#pragma unroll
                for (int bj = 0; bj < 2; ++bj) { bf16_t* p = ob + ((size_t)((b * 8 + h0 + bj) * 4096 + sp)) * 128 + dcol;
                    *(u32x4*)p = pack8(acc[ai][bj][m][0], acc[ai][bj][m][1]); } }
    }
};
struct EpiRes {
    static constexpr bool PERM = false, AFTER_DRAIN = false;
    const float* base; float* out; const float* gate;
    __device__ __forceinline__ void operator()(const f32x4 (&acc)[2][2][4][2], const Unit& u, int wr, int wc, int fr, int fq) const {
        const int row0 = u.pm * BM + wr * 64 + fr, col0 = u.pn * BM + wc * 32 + 4 * fq, b = (u.pm * BM) >> 12;
        f32x4 gv[2][2];
#pragma unroll
        for (int bj = 0; bj < 2; ++bj)
#pragma unroll
            for (int n = 0; n < 2; ++n) gv[bj][n] = *(const f32x4*)(gate + b * 6144 + col0 + bj * HALF + n * 16);
#pragma unroll
        for (int ai = 0; ai < 2; ++ai)
#pragma unroll
            for (int m = 0; m < 4; ++m) { const size_t off = (size_t)(row0 + ai * HALF + m * 16) * 1024 + col0;
#pragma unroll
                for (int bj = 0; bj < 2; ++bj)
#pragma unroll
                    for (int n = 0; n < 2; ++n) { const f32x4 bs = *(const f32x4*)(base + off + bj * HALF + n * 16);
                        *(f32x4*)(out + off + bj * HALF + n * 16) = bs + gv[bj][n] * acc[ai][bj][m][n]; } }
    }
};
struct EpiSwiGLU {
    static constexpr bool PERM = true, AFTER_DRAIN = false;
    bf16_t* H; int ldh;
    __device__ __forceinline__ void operator()(const f32x4 (&acc)[2][2][4][2], const Unit& u, int wr, int wc, int fr, int fq) const {
        const int row0 = u.pm * BM + wr * 64 + fr, col0 = u.pn * HALF + wc * 32 + 8 * fq;
#pragma unroll
        for (int ai = 0; ai < 2; ++ai)
#pragma unroll
            for (int m = 0; m < 4; ++m) { f32x4 r0, r1;
#pragma unroll
                for (int i = 0; i < 4; ++i) { r0[i] = silu_f(acc[ai][0][m][0][i]) * acc[ai][1][m][0][i]; r1[i] = silu_f(acc[ai][0][m][1][i]) * acc[ai][1][m][1][i]; }
                *(u32x4*)(H + (size_t)(row0 + ai * HALF + m * 16) * ldh + col0) = pack8(r0, r1); }
    }
};
struct EpiHgrnNaive {
    static constexpr bool PERM = true, AFTER_DRAIN = false;
    bf16_t* QS; float* FG; bf16_t* V; bf16_t* SG; const float* lbs;
    __device__ __forceinline__ void operator()(const f32x4 (&acc)[2][2][4][2], const Unit& u, int wr, int wc, int fr, int fq) const {
        typedef unsigned u32x2 __attribute__((ext_vector_type(2)));
        const int head = u.pn >> 1, type = u.pn & 1, col0 = head * 128 + wc * 32 + 8 * fq, row0 = u.pm * BM + wr * 64 + fr;
#pragma unroll
        for (int n = 0; n < 2; ++n) {
            const f32x4 lb = *(const f32x4*)(lbs + col0 + 4 * n);
#pragma unroll
            for (int ai = 0; ai < 2; ++ai)
#pragma unroll
                for (int m = 0; m < 4; ++m) { const size_t off = (size_t)(row0 + ai * HALF + m * 16) * 1024 + col0 + 4 * n; f32x4 a, b;
                    if (type == 0) {
#pragma unroll
                        for (int i = 0; i < 4; ++i) { a[i] = silu_f(acc[ai][0][m][n][i]); b[i] = lb[i] + (1.0f - lb[i]) * sigmoid_f(acc[ai][1][m][n][i]); }
                        u32x2 w; w.x = cvt_pk_bf16(a[0], a[1]); w.y = cvt_pk_bf16(a[2], a[3]); *(u32x2*)(QS + off) = w; *(f32x4*)(FG + off) = b;
                    } else {
#pragma unroll
                        for (int i = 0; i < 4; ++i) { a[i] = acc[ai][0][m][n][i]; b[i] = silu_f(acc[ai][1][m][n][i]); }
                        u32x2 w; w.x = cvt_pk_bf16(a[0], a[1]); w.y = cvt_pk_bf16(a[2], a[3]); *(u32x2*)(V + off) = w;
                        u32x2 x; x.x = cvt_pk_bf16(b[0], b[1]); x.y = cvt_pk_bf16(b[2], b[3]); *(u32x2*)(SG + off) = x;
                    }
                    asm volatile("" ::: "memory"); }
        }
    }
};

#define PG8_DPP(v, ctrl, bc) __builtin_bit_cast(float, __builtin_amdgcn_update_dpp(0, __builtin_bit_cast(int, (v)), (ctrl), 0xF, 0xF, (bc)))
struct EpiHgrn {
    static constexpr bool PERM = true, AFTER_DRAIN = false;
    bf16_t* QB; bf16_t* KD; bf16_t* KE; float* DEC; bf16_t* V; bf16_t* SG; const float* lbs;
    __device__ __forceinline__ void operator()(const f32x4 (&acc)[2][2][4][2], const Unit& u, int wr, int wc, int fr, int fq) const {
        typedef unsigned u32x2 __attribute__((ext_vector_type(2)));
        const int head = u.pn >> 1, type = u.pn & 1, col0 = head * 128 + wc * 32 + 8 * fq, row0 = u.pm * BM + wr * 64 + fr;
#pragma unroll
        for (int n = 0; n < 2; ++n) {
            const f32x4 lb = *(const f32x4*)(lbs + col0 + 4 * n);
#pragma unroll
            for (int ai = 0; ai < 2; ++ai)
#pragma unroll
                for (int m = 0; m < 4; ++m) { const int row = row0 + ai * HALF + m * 16; const size_t off = (size_t)row * 1024 + col0 + 4 * n;
                    if (type == 0) { f32x4 qb, kd, ke, dc;
#pragma unroll
                        for (int i = 0; i < 4; ++i) { const float q = acc[ai][0][m][n][i], f = acc[ai][1][m][n][i];
                            const float ea = __expf(-fabsf(f)), shi = __builtin_amdgcn_rcpf(1.0f + ea), slo = ea * shi, oml = 1.0f - lb[i];
                            const float sg = f >= 0.f ? shi : slo, fg = lb[i] + oml * sg, kin = oml * (f >= 0.f ? slo : shi), lf = __logf(fg);
                            float G = lf;
                            G += PG8_DPP(G, 0x111, true); G += PG8_DPP(G, 0x112, true); G += PG8_DPP(G, 0x114, true); G += PG8_DPP(G, 0x118, true);
                            float T = lf;
                            T += PG8_DPP(T, 0xB1, false); T += PG8_DPP(T, 0x4E, false); T += PG8_DPP(T, 0x141, false); T += PG8_DPP(T, 0x140, false);
                            qb[i] = silu_f(q) * __expf(G); ke[i] = kin * __expf(T - G); kd[i] = kin * __expf(fminf(-G, 80.0f)); dc[i] = __expf(T); }
                        u32x2 w; w.x = cvt_pk_bf16(qb[0], qb[1]); w.y = cvt_pk_bf16(qb[2], qb[3]); *(u32x2*)(QB + off) = w;
                        w.x = cvt_pk_bf16(kd[0], kd[1]); w.y = cvt_pk_bf16(kd[2], kd[3]); *(u32x2*)(KD + off) = w;
                        w.x = cvt_pk_bf16(ke[0], ke[1]); w.y = cvt_pk_bf16(ke[2], ke[3]); *(u32x2*)(KE + off) = w;
                        if (fr == 0) *(f32x4*)(DEC + (size_t)(row >> 4) * 1024 + col0 + 4 * n) = dc;
                    } else { f32x4 a, b;
#pragma unroll
                        for (int i = 0; i < 4; ++i) { a[i] = acc[ai][0][m][n][i]; b[i] = silu_f(acc[ai][1][m][n][i]); }
                        u32x2 w; w.x = cvt_pk_bf16(a[0], a[1]); w.y = cvt_pk_bf16(a[2], a[3]); *(u32x2*)(V + off) = w;
                        u32x2 x; x.x = cvt_pk_bf16(b[0], b[1]); x.y = cvt_pk_bf16(b[2], b[3]); *(u32x2*)(SG + off) = x;
                    }
                    asm volatile("" ::: "memory"); }
        }
    }
};

template <class Epi, class Sched, bool ALIGN_EPI = false, bool SP2 = false>
__device__ __forceinline__ void gemm_phase(PG8_LAS unsigned char* lds, const Gemm g, const Sched& S, const Epi& E, const int wave_) {
    const int tid_ = fresh_tid(__builtin_amdgcn_readfirstlane(wave_));
    const int tid = tid_, wid = __builtin_amdgcn_readfirstlane(tid >> 6), lane = tid & 63, wr = wid >> 2, wc = wid & 3, fr = lane & 15, fq = lane >> 4;
    const int K = g.K, nt = K / BK;
    unsigned voffA[2], voffB[2];
#pragma unroll
    for (int i = 0; i < 2; ++i) { int R, C; stage_rc(tid * 16 + i * 8192, R, C); const int Rb = Epi::PERM ? ((R & ~31) + perm32(R & 31)) : R;
        voffA[i] = (unsigned)(R * K + C) * 2u; voffB[i] = (unsigned)(Rb * K + C) * 2u; }
    const size_t kstep = (size_t)(BK * 2);
    const size_t hstep = (size_t)HALF * K * 2;
    const size_t tstep = 2 * hstep;
    const unsigned ldsw = (unsigned)wid * 1024u;
    const int aoff = lds_byte(wr * 64 + fr, fq * 8), boff = lds_byte(wc * 32 + fr, fq * 8);
#define PG8_SA(b, h) (((b) * 2 + (h)) * HTB)
#define PG8_SB(b, h) ((4 + (b) * 2 + (h)) * HTB)
#define PG8_STAGE(bufoff, gbase, voff) do { _Pragma("unroll") for (int _i = 0; _i < 2; ++_i) \
        __builtin_amdgcn_global_load_lds((const unsigned*)((const char*)(gbase) + (voff)[_i]), (PG8_LAS unsigned*)(lds + (bufoff) + ldsw + _i * 8192), 16, 0, 0); } while (0)
#define PG8_LDA(dst, b, h) do { _Pragma("unroll") for (int m = 0; m < 4; ++m) _Pragma("unroll") for (int k = 0; k < 2; ++k) dst[m][k] = *(const PG8_LAS bf16x8*)(lds + PG8_SA(b, h) + aoff + m * 2048 + k * 1024); } while (0)
#define PG8_LDB(dst, b, h) do { _Pragma("unroll") for (int n = 0; n < 2; ++n) _Pragma("unroll") for (int k = 0; k < 2; ++k) dst[n][k] = *(const PG8_LAS bf16x8*)(lds + PG8_SB(b, h) + boff + n * 2048 + k * 1024); } while (0)
#define PG8_MMA(ai, bj, At, Bt) do { __builtin_amdgcn_s_setprio(1); _Pragma("unroll") for (int m = 0; m < 4; ++m) _Pragma("unroll") for (int n = 0; n < 2; ++n) _Pragma("unroll") for (int k = 0; k < 2; ++k) \
        acc[ai][bj][m][n] = __builtin_amdgcn_mfma_f32_16x16x32_bf16(Bt[n][k], At[m][k], acc[ai][bj][m][n], 0, 0, 0); __builtin_amdgcn_s_setprio(0); } while (0)
#define PG8_WAIT_V(n) asm volatile("s_waitcnt vmcnt(" #n ")" ::: "memory")
#define PG8_WAIT_L(n) asm volatile("s_waitcnt lgkmcnt(" #n ")" ::: "memory")
#define PG8_BAR __builtin_amdgcn_s_barrier()
#define PG8_SCHED __builtin_amdgcn_sched_barrier(0)
    Unit cur, nxt; int ui = 0;
    if (!S.next(0, cur)) return;
    f32x4 acc[2][2][4][2];
#pragma unroll
    for (int a = 0; a < 2; ++a)
#pragma unroll
        for (int b = 0; b < 2; ++b)
#pragma unroll
            for (int m = 0; m < 4; ++m)
#pragma unroll
                for (int n = 0; n < 2; ++n) acc[a][b][m][n] = (f32x4){0.f, 0.f, 0.f, 0.f};
    bf16x8 At[4][2], B0[2][2], B1[2][2];
    const char* cA = (const char*)g.A + (size_t)cur.pm * tstep; const char* cB = (const char*)g.Bt + (size_t)cur.pn * tstep;
    S.a_ready(cur);
    if constexpr (SP2) {
        PG8_STAGE(PG8_SB(0, 0), cB, voffB); PG8_STAGE(PG8_SB(0, 1), cB + hstep, voffB); PG8_STAGE(PG8_SA(0, 0), cA, voffA); PG8_STAGE(PG8_SA(0, 1), cA + hstep, voffA);
        if (wr == 1) PG8_BAR;
        PG8_WAIT_V(2); PG8_BAR;
        PG8_STAGE(PG8_SB(1, 0), cB + kstep, voffB); PG8_STAGE(PG8_SA(1, 0), cA + kstep, voffA); PG8_STAGE(PG8_SB(1, 1), cB + hstep + kstep, voffB);
        PG8_WAIT_V(6); PG8_BAR;
    } else {
        PG8_STAGE(PG8_SB(0, 0), cB, voffB); PG8_STAGE(PG8_SA(0, 0), cA, voffA); PG8_STAGE(PG8_SB(0, 1), cB + hstep, voffB); PG8_STAGE(PG8_SA(0, 1), cA + hstep, voffA);
        if (wr == 1) PG8_BAR;
        PG8_WAIT_V(4); PG8_BAR;
        PG8_STAGE(PG8_SB(1, 0), cB + kstep, voffB); PG8_STAGE(PG8_SA(1, 0), cA + kstep, voffA); PG8_STAGE(PG8_SB(1, 1), cB + hstep + kstep, voffB);
        PG8_WAIT_V(6); PG8_BAR;
    }
    for (;;) {
        const bool has_next = S.next(ui + 1, nxt);
        const char* nA = has_next ? (const char*)g.A + (size_t)nxt.pm * tstep : cA; const char* nB = has_next ? (const char*)g.Bt + (size_t)nxt.pn * tstep : cB;
        for (int t = 0; t < nt; t += 2) {
            const bool last = (t == nt - 2);
            const char* a1 = cA + (size_t)(t + 1) * kstep;
            const char* a2 = last ? nA : cA + (size_t)(t + 2) * kstep; const char* b2 = last ? nB : cB + (size_t)(t + 2) * kstep;
            const char* a3 = a2 + kstep; const char* b3 = b2 + kstep;
            if (last && has_next) S.a_ready(nxt);
            if constexpr (SP2) {
            PG8_LDB(B0, 0, 0); PG8_LDB(B1, 0, 1); PG8_SCHED; PG8_LDA(At, 0, 0); PG8_STAGE(PG8_SA(1, 1), a1 + hstep, voffA);
            PG8_WAIT_V(8); PG8_WAIT_L(0); PG8_BAR; PG8_MMA(0, 0, At, B0); PG8_MMA(0, 1, At, B1); PG8_BAR; PG8_SCHED;
            PG8_LDA(At, 0, 1); PG8_STAGE(PG8_SB(0, 0), b2, voffB); PG8_STAGE(PG8_SB(0, 1), b2 + hstep, voffB); PG8_STAGE(PG8_SA(0, 0), a2, voffA);
            PG8_WAIT_V(8); PG8_WAIT_L(0); PG8_BAR; PG8_MMA(1, 0, At, B0); PG8_MMA(1, 1, At, B1); PG8_BAR; PG8_SCHED;
            PG8_LDB(B0, 1, 0); PG8_LDB(B1, 1, 1); PG8_SCHED; PG8_LDA(At, 1, 0); PG8_STAGE(PG8_SA(0, 1), a2 + hstep, voffA);
            PG8_WAIT_V(8); PG8_WAIT_L(0); PG8_BAR; PG8_MMA(0, 0, At, B0); PG8_MMA(0, 1, At, B1); PG8_BAR; PG8_SCHED;
            PG8_LDA(At, 1, 1); PG8_STAGE(PG8_SB(1, 0), b3, voffB); PG8_STAGE(PG8_SB(1, 1), b3 + hstep, voffB); PG8_STAGE(PG8_SA(1, 0), a3, voffA);
            PG8_WAIT_V(8); PG8_WAIT_L(0); PG8_BAR; PG8_MMA(1, 0, At, B0); PG8_MMA(1, 1, At, B1); PG8_BAR; PG8_SCHED;
            } else {
            PG8_LDB(B0, 0, 0); PG8_SCHED; PG8_LDA(At, 0, 0); PG8_STAGE(PG8_SA(1, 1), a1 + hstep, voffA);
            PG8_WAIT_L(8); PG8_BAR; PG8_WAIT_L(0); PG8_MMA(0, 0, At, B0); PG8_BAR; PG8_SCHED;
            PG8_LDB(B1, 0, 1); PG8_STAGE(PG8_SB(0, 0), b2, voffB);
            PG8_BAR; PG8_WAIT_L(0); PG8_MMA(0, 1, At, B1); PG8_BAR;
            PG8_LDA(At, 0, 1); PG8_STAGE(PG8_SA(0, 0), a2, voffA);
            PG8_BAR; PG8_WAIT_L(0); PG8_MMA(1, 0, At, B0); PG8_BAR; PG8_SCHED;
            PG8_STAGE(PG8_SB(0, 1), b2 + hstep, voffB);
            PG8_WAIT_V(6); PG8_BAR; PG8_MMA(1, 1, At, B1); PG8_BAR;
            PG8_LDB(B0, 1, 0); PG8_SCHED; PG8_LDA(At, 1, 0); PG8_STAGE(PG8_SA(0, 1), a2 + hstep, voffA);
            PG8_WAIT_L(8); PG8_BAR; PG8_WAIT_L(0); PG8_MMA(0, 0, At, B0); PG8_BAR; PG8_SCHED;
            PG8_LDB(B1, 1, 1); PG8_STAGE(PG8_SB(1, 0), b3, voffB);
            PG8_BAR; PG8_WAIT_L(0); PG8_MMA(0, 1, At, B1); PG8_BAR;
            PG8_LDA(At, 1, 1); PG8_STAGE(PG8_SA(1, 0), a3, voffA);
            PG8_BAR; PG8_WAIT_L(0); PG8_MMA(1, 0, At, B0); PG8_BAR; PG8_SCHED;
            PG8_STAGE(PG8_SB(1, 1), b3 + hstep, voffB);
            PG8_WAIT_V(6); PG8_BAR; PG8_MMA(1, 1, At, B1); PG8_BAR;
            }
        }
        if constexpr (ALIGN_EPI) { if (wr == 0) PG8_BAR; }
        if constexpr (!Epi::AFTER_DRAIN) { E(acc, cur, wr, wc, fr, fq); S.done(cur); }
        if (!has_next) break;
#pragma unroll
        for (int a = 0; a < 2; ++a)
#pragma unroll
            for (int b = 0; b < 2; ++b)
#pragma unroll
                for (int m = 0; m < 4; ++m)
#pragma unroll
                    for (int n = 0; n < 2; ++n) acc[a][b][m][n] = (f32x4){0.f, 0.f, 0.f, 0.f};
        cur = nxt; cA = nA; cB = nB; ++ui;
        if constexpr (ALIGN_EPI) { if (wr == 1) PG8_BAR; }
    }
    PG8_WAIT_V(0);
    if constexpr (!ALIGN_EPI) { if (wr == 0) PG8_BAR; }
    PG8_BAR;
    if constexpr (Epi::AFTER_DRAIN) { E.fused(acc, cur, wr, wc, fr, fq, lds, wid, lane); S.done(cur); }
#undef PG8_SA
#undef PG8_SB
#undef PG8_STAGE
#undef PG8_LDA
#undef PG8_LDB
#undef PG8_MMA
#undef PG8_WAIT_V
#undef PG8_WAIT_L
#undef PG8_BAR
#undef PG8_SCHED
}
}
#define GAS __attribute__((address_space(1)))
#define LAS __attribute__((address_space(3)))
typedef unsigned short bf16;
typedef unsigned v4u __attribute__((ext_vector_type(4)));
typedef float f32x4 __attribute__((ext_vector_type(4)));
typedef short bf16x8 __attribute__((ext_vector_type(8)));
typedef GAS unsigned gu32;
typedef GAS unsigned long long gu64;
#define RLX_AGENT __ATOMIC_RELAXED, __HIP_MEMORY_SCOPE_AGENT
#define LDS_WAIT() asm volatile("s_waitcnt lgkmcnt(0)" ::: "memory")
#define VM_WAIT() asm volatile("s_waitcnt vmcnt(0)" ::: "memory")
__device__ __forceinline__ unsigned long long rt() { return __builtin_amdgcn_s_memrealtime(); }
__device__ __forceinline__ unsigned f2bf(float f) { unsigned u = __builtin_bit_cast(unsigned, f); return (u + 0x7fffu + ((u >> 16) & 1u)) >> 16; }
__device__ __forceinline__ unsigned pk2(float lo, float hi) { return f2bf(lo) | (f2bf(hi) << 16); }

#define XB_TMO      128
#define XB_XCNT(j)  (256  + 64 * (j))
#define XB_XSUB(j)  (1280 + 64 * (j))
#define XB_XGEN(j)  (2304 + 64 * (j))
#define XB_TOP      3328
#define XB_TOPGEN   3392
#define XCD_BAR_WORDS 3456
#define XB_SPIN_CAP (1u << 18)

__device__ __forceinline__ unsigned xb_ld(unsigned* p)              { return __hip_atomic_load(p, __ATOMIC_RELAXED, __HIP_MEMORY_SCOPE_AGENT); }
__device__ __forceinline__ unsigned xb_add(unsigned* p, unsigned v) { return __hip_atomic_fetch_add(p, v, __ATOMIC_RELAXED, __HIP_MEMORY_SCOPE_AGENT); }
__device__ __forceinline__ unsigned xb_xcc_id() { return (unsigned)__builtin_amdgcn_s_getreg((3 << 11) | 20) & 0xFu; }
#define XB_SPIN(cond, bar) do { unsigned _sp = 0; while (cond) { __builtin_amdgcn_s_sleep(1); \
    if ((++_sp & 255u) == 0u) { if (xb_ld(&(bar)[XB_TMO])) break; if (_sp > XB_SPIN_CAP) { atomicAdd(&(bar)[XB_TMO], 1u); break; } } } } while (0)


struct XcdBarrier {
    unsigned* bar; unsigned x; int wave;
    volatile LAS unsigned* st;
};

__device__ __forceinline__ XcdBarrier xcd_barrier_post(unsigned* bar, volatile LAS unsigned* st, int wave) {
    XcdBarrier b; b.bar = bar; b.x = xb_xcc_id(); b.st = st; b.wave = wave;
    if (fresh_tid(wave) == 0) (void)xb_add(&bar[XB_XCNT(b.x)], 1u);
    return b;
}
__device__ __forceinline__ void xcd_barrier_complete(unsigned* bar, unsigned x, unsigned& nloc, unsigned& nx) {
    const unsigned G = gridDim.x * gridDim.y * gridDim.z;
    unsigned sum, cnt, mine, sp = 0u;
    for (;;) {
        sum = 0u; cnt = 0u; mine = 0u;
#pragma unroll
        for (unsigned j = 0; j < 16; ++j) { const unsigned c = xb_ld(&bar[XB_XCNT(j)]); sum += c; cnt += (c > 0u) ? 1u : 0u; mine = (j == x) ? c : mine; }
        if (sum == G) break;
        __builtin_amdgcn_s_sleep(1);
        if ((++sp & 255u) == 0u) { if (xb_ld(&bar[XB_TMO])) break; if (sp > XB_SPIN_CAP) { atomicAdd(&bar[XB_TMO], 1u); break; } }
    }
    nloc = mine > 0u ? mine : 1u; nx = cnt > 0u ? cnt : 1u;
}

__device__ __forceinline__ void xcd_barrier(const XcdBarrier& b) {
    asm volatile("s_waitcnt vmcnt(0)" ::: "memory");
    __syncthreads();
    if (fresh_tid(b.wave) == 0) {
        unsigned* bar = b.bar;
        __builtin_amdgcn_s_waitcnt(0);
        unsigned nloc = b.st[0], nx = b.st[1];
        if (nloc == 0u) { xcd_barrier_complete(bar, b.x, nloc, nx); b.st[0] = nloc; b.st[1] = nx; }
        const unsigned old = xb_add(&bar[XB_XSUB(b.x)], 1u);
        const unsigned gen = old / nloc;
        if (old + 1u == (gen + 1u) * nloc) {
            __builtin_amdgcn_fence(__ATOMIC_RELEASE, "agent");
            asm volatile("s_waitcnt vmcnt(0)" ::: "memory");
            const unsigned og = xb_add(&bar[XB_TOP], 1u);
            const unsigned tg = og / nx;
            if (og + 1u == (tg + 1u) * nx) xb_add(&bar[XB_TOPGEN], 1u);
            else XB_SPIN(xb_ld(&bar[XB_TOPGEN]) == tg, bar);
            __builtin_amdgcn_fence(__ATOMIC_ACQUIRE, "agent");
            xb_add(&bar[XB_XGEN(b.x)], 1u);
            asm volatile("s_waitcnt vmcnt(0)" ::: "memory");
        } else {
            XB_SPIN(xb_ld(&bar[XB_XGEN(b.x)]) == gen, bar);
            __builtin_amdgcn_fence(__ATOMIC_ACQUIRE, "agent");
            asm volatile("s_waitcnt vmcnt(0)" ::: "memory");
        }
    }
    __syncthreads();
}

namespace att {
#define ATT_LAS __attribute__((address_space(3)))
typedef unsigned short bf16_t;
typedef short bf16x8 __attribute__((ext_vector_type(8)));
typedef short s16x4 __attribute__((ext_vector_type(4)));
typedef float f32x16 __attribute__((ext_vector_type(16)));
typedef float f32x4 __attribute__((ext_vector_type(4)));
typedef unsigned u32x4 __attribute__((ext_vector_type(4)));
typedef ATT_LAS char* lptr;
constexpr int D = 128, NW = 8, QBLK = 32, KVBLK = 64, QB = NW * QBLK, W = 129;
constexpr int SHM_V = KVBLK * D * 2, SHM_K = KVBLK * D * 2;
constexpr int LDS_WSC = 2 * SHM_V + 2 * SHM_K;
constexpr int LUTW = 320, LUT_OFF = 96;
constexpr int LDS_LUT = LDS_WSC + NW * 64 * 4;
constexpr int LDS_BYTES = LDS_LUT + 8 * LUTW * 4;
constexpr float SCALE = 0.08838834764831845f, THR = 0.f, EPS = 1e-6f;
constexpr bool SK = true;

#define KSWZ(row, colB) ((row) * 256 + ((colB) ^ (((row) & 7) << 4)))
#define SBAR() __builtin_amdgcn_sched_barrier(0)
__device__ __forceinline__ int v_st(int k, int c) { const int kk = (k & ~0xC) | ((k & 4) << 1) | ((k & 8) >> 1); return ((kk >> 3) * 4 + (c >> 5)) * 512 + ((kk & 7) * 32 + (c & 31)) * 2; }
__device__ __forceinline__ int v_rd_base(int lane) { return ((lane & 3) << 3) | (((lane >> 2) & 3) << 6) | (((lane >> 4) & 1) << 5) | (((lane >> 5) & 1) << 8); }
constexpr int v_rd_off(int d0, int ks, int half) { return d0 * 512 + ks * 4096 + half * 2048; }
__device__ __forceinline__ int crow(int r, int hi) { return (r & 3) + 8 * (r >> 2) + 4 * hi; }
__device__ __forceinline__ unsigned cvtpk(float lo, float hi) { unsigned r; asm volatile("v_cvt_pk_bf16_f32 %0, %1, %2" : "=v"(r) : "v"(lo), "v"(hi)); return r; }
__device__ __forceinline__ float bfe(bf16x8 v, int j) { return __builtin_bit_cast(float, (unsigned)(unsigned short)v[j] << 16); }
__device__ __forceinline__ float dpp_sum16(float v) {
    v += __builtin_bit_cast(float, __builtin_amdgcn_update_dpp(0, __builtin_bit_cast(int, v), 0xB1, 0xF, 0xF, false));
    v += __builtin_bit_cast(float, __builtin_amdgcn_update_dpp(0, __builtin_bit_cast(int, v), 0x4E, 0xF, 0xF, false));
    v += __builtin_bit_cast(float, __builtin_amdgcn_update_dpp(0, __builtin_bit_cast(int, v), 0x141, 0xF, 0xF, false));
    v += __builtin_bit_cast(float, __builtin_amdgcn_update_dpp(0, __builtin_bit_cast(int, v), 0x140, 0xF, 0xF, false));
    return v;
}
__device__ __forceinline__ bf16x8 knorm(bf16x8 k) {
    float f[8]; float ss = 0.f;
#pragma unroll
    for (int j = 0; j < 8; ++j) { f[j] = bfe(k, j); ss += f[j] * f[j]; }
    const float rs = __builtin_amdgcn_rsqf(dpp_sum16(ss) * (1.0f / D) + EPS);
    u32x4 w = {cvtpk(f[0] * rs, f[1] * rs), cvtpk(f[2] * rs, f[3] * rs), cvtpk(f[4] * rs, f[5] * rs), cvtpk(f[6] * rs, f[7] * rs)};
    return __builtin_bit_cast(bf16x8, w);
}
__device__ __forceinline__ void q_normalize(bf16x8* qr, const float* gq, int hi) {
    float ss = 0.f;
#pragma unroll
    for (int d0 = 0; d0 < 8; ++d0)
#pragma unroll
        for (int j = 0; j < 8; ++j) { const float f = bfe(qr[d0], j); ss += f * f; }
    { auto rr = __builtin_amdgcn_permlane32_swap(__float_as_uint(ss), __float_as_uint(ss), false, false); ss = __uint_as_float(rr[0]) + __uint_as_float(rr[1]); }
    const float rs = __builtin_amdgcn_rsqf(ss * (1.0f / D) + EPS);
#pragma unroll
    for (int d0 = 0; d0 < 8; ++d0) { const f32x4 g0 = *(const f32x4*)((const char*)gq + (unsigned)(hi * 32) + d0 * 64), g1 = *(const f32x4*)((const char*)gq + (unsigned)(hi * 32) + d0 * 64 + 16);
        u32x4 w = {cvtpk(bfe(qr[d0], 0) * rs * g0[0], bfe(qr[d0], 1) * rs * g0[1]), cvtpk(bfe(qr[d0], 2) * rs * g0[2], bfe(qr[d0], 3) * rs * g0[3]),
                   cvtpk(bfe(qr[d0], 4) * rs * g1[0], bfe(qr[d0], 5) * rs * g1[1]), cvtpk(bfe(qr[d0], 6) * rs * g1[2], bfe(qr[d0], 7) * rs * g1[3])};
        qr[d0] = __builtin_bit_cast(bf16x8, w); }
}
__device__ __forceinline__ void mask_tile(f32x16& p0, f32x16& p1, int dq, unsigned Wn) {
    const float NEG = -__builtin_inff();
#pragma unroll
    for (int r = 0; r < 16; ++r) { const int c = (r & 3) + 8 * (r >> 2);
        if ((unsigned)(dq - c) >= Wn) p0[r] = NEG;
        if ((unsigned)(dq - c - 32) >= Wn) p1[r] = NEG; }
}
__device__ __forceinline__ void bias_tile(f32x16& p0, f32x16& p1, const ATT_LAS float* lb) {
#pragma unroll
    for (int r = 0; r < 16; ++r) { const int c = (r & 3) + 8 * (r >> 2); p0[r] += lb[63 - c]; p1[r] += lb[31 - c]; }
}
__device__ __forceinline__ void partialSM(f32x16& p0, f32x16& p1, float& m_reg, float& mn, float& alpha) {
    float pmax = p0[0];
#pragma unroll
    for (int r = 1; r < 16; ++r) pmax = fmaxf(pmax, p0[r]);
#pragma unroll
    for (int r = 0; r < 16; ++r) pmax = fmaxf(pmax, p1[r]);
    { auto rr = __builtin_amdgcn_permlane32_swap(__float_as_uint(pmax), __float_as_uint(pmax), false, false);
      pmax = fmaxf(__uint_as_float(rr[0]), __uint_as_float(rr[1])); }
    constexpr float C2 = 1.4426950408889634f * SCALE;
    if (__builtin_expect(__all((pmax - m_reg) * SCALE <= THR), 1)) { mn = m_reg; alpha = 1.f; }
    else { mn = fmaxf(m_reg, pmax); alpha = __builtin_amdgcn_exp2f((m_reg - mn) * C2); m_reg = mn; }
    const float mnL = -mn * C2;
#pragma unroll
    for (int r = 0; r < 16; ++r) p0[r] = fmaf(p0[r], C2, mnL);
#pragma unroll
    for (int r = 0; r < 16; ++r) p1[r] = fmaf(p1[r], C2, mnL);
#pragma unroll
    for (int r = 0; r < 16; ++r) p0[r] = __builtin_amdgcn_exp2f(p0[r]);
}
__device__ __forceinline__ void finishSM(f32x16& p0, f32x16& p1, float alpha, float& l_reg, bf16x8& pa0, bf16x8& pa1, bf16x8& pa2, bf16x8& pa3) {
#pragma unroll
    for (int r = 0; r < 16; ++r) p1[r] = __builtin_amdgcn_exp2f(p1[r]);
    float ps = 0;
#pragma unroll
    for (int r = 0; r < 16; ++r) ps += p0[r];
#pragma unroll
    for (int r = 0; r < 16; ++r) ps += p1[r];
    { auto rr = __builtin_amdgcn_permlane32_swap(__float_as_uint(ps), __float_as_uint(ps), false, false);
      ps = __uint_as_float(rr[0]) + __uint_as_float(rr[1]); }
    l_reg = l_reg * alpha + ps;
#define PK4(P, B_, OUT) do { unsigned a0 = cvtpk(P[B_+0], P[B_+1]), a1 = cvtpk(P[B_+2], P[B_+3]);                          \
        unsigned b0 = cvtpk(P[B_+4], P[B_+5]), b1 = cvtpk(P[B_+6], P[B_+7]);                                             \
        auto r0 = __builtin_amdgcn_permlane32_swap(a0, b0, false, false); auto r1 = __builtin_amdgcn_permlane32_swap(a1, b1, false, false); \
        u32x4 w = {r0[0], r1[0], r0[1], r1[1]}; OUT = __builtin_bit_cast(bf16x8, w); } while (0)
    PK4(p0, 0, pa0); PK4(p0, 8, pa1); PK4(p1, 0, pa2); PK4(p1, 8, pa3);
#undef PK4
}
template <int KB>
__device__ __forceinline__ void qkt(f32x16& p0, f32x16& p1, lptr K_lds, int r32, int hi, const bf16x8* qr, bool act) {
    if (SK && !act) { const float NEG = -__builtin_inff();
#pragma unroll
        for (int r = 0; r < 16; ++r) { p0[r] = NEG; p1[r] = NEG; } return; }
    p0 = f32x16{}; p1 = f32x16{};
    lptr kb[4];
#pragma unroll
    for (int dd = 0; dd < 4; ++dd) kb[dd] = K_lds + KB * SHM_K + KSWZ(r32, (dd * 16 + hi * 8) * 2);
#pragma unroll
    for (int d0 = 0; d0 < 8; ++d0) { lptr a = kb[d0 & 3] + (d0 >> 2) * 128;
        bf16x8 b0 = *(const ATT_LAS bf16x8*)(a);
        bf16x8 b1 = *(const ATT_LAS bf16x8*)(a + 32 * 256);
        p0 = __builtin_amdgcn_mfma_f32_32x32x16_bf16(b0, qr[d0], p0, 0, 0, 0);
        p1 = __builtin_amdgcn_mfma_f32_32x32x16_bf16(b1, qr[d0], p1, 0, 0, 0); }
}
template <int VB>
__device__ __forceinline__ void pv_tile(f32x16* o, int vb0, bf16x8 pa0, bf16x8 pa1, bf16x8 pa2, bf16x8 pa3, bool act) {
    if (SK && !act) return;
#define TRRD(dst, off) asm volatile("ds_read_b64_tr_b16 %0, %1 offset:%2" : "=&v"(dst) : "v"(vb0), "i"(off) : "memory")
#define PV_D0(d0) do { s16x4 l0, l1, l2, l3, h0, h1, h2, h3; constexpr int b_ = VB * SHM_V + v_rd_off(d0, 0, 0); \
        TRRD(l0, b_); TRRD(h0, b_ + 2048); TRRD(l1, b_ + 4096); TRRD(h1, b_ + 6144); TRRD(l2, b_ + 8192); TRRD(h2, b_ + 10240); TRRD(l3, b_ + 12288); TRRD(h3, b_ + 14336); \
        asm volatile("s_waitcnt lgkmcnt(0)" ::: "memory"); SBAR();   \
        o[d0] = __builtin_amdgcn_mfma_f32_32x32x16_bf16(pa0, (bf16x8){l0[0], l0[1], l0[2], l0[3], h0[0], h0[1], h0[2], h0[3]}, o[d0], 0, 0, 0);   \
        o[d0] = __builtin_amdgcn_mfma_f32_32x32x16_bf16(pa1, (bf16x8){l1[0], l1[1], l1[2], l1[3], h1[0], h1[1], h1[2], h1[3]}, o[d0], 0, 0, 0);   \
        o[d0] = __builtin_amdgcn_mfma_f32_32x32x16_bf16(pa2, (bf16x8){l2[0], l2[1], l2[2], l2[3], h2[0], h2[1], h2[2], h2[3]}, o[d0], 0, 0, 0);   \
        o[d0] = __builtin_amdgcn_mfma_f32_32x32x16_bf16(pa3, (bf16x8){l3[0], l3[1], l3[2], l3[3], h3[0], h3[1], h3[2], h3[3]}, o[d0], 0, 0, 0); } while (0)
    PV_D0(0); PV_D0(1); PV_D0(2); PV_D0(3);
#undef PV_D0
#undef TRRD
}

struct BlockRef { const bf16_t* Q; const bf16_t* K; const bf16_t* V; bf16_t* O; float* LSE; int P0, lut; };
struct Seam { bf16x8 qr[8]; bf16x8 st_v0, st_v1, st_k0, st_k1; };
struct PhaseConst { int skv, ostr, lstr; const float* gq; };
__device__ __forceinline__ int swa_jlo(int P0) { const int lowk = P0 - W + 1; return lowk > 0 ? lowk / KVBLK : 0; }
#define ROW(p, k0, rr) ((const char*)((p) + (size_t)((k0) + (rr)) * D) + kvoff)
#define VMW() asm volatile("s_waitcnt vmcnt(0)" ::: "memory")
#define VMWN(n) asm volatile("s_waitcnt vmcnt(%0)" :: "i"(n) : "memory")
#define LD8(p) (*reinterpret_cast<const bf16x8*>(p))
#define QROWP(Qp, wid) ((const char*)((Qp) + (size_t)((wid) * QBLK) * D) + qoff)
#define SLOAD_H(Kp, Vp, k0) do { S.st_v0 = LD8(ROW(Vp, k0, 0)); S.st_v1 = LD8(ROW(Vp, k0, 32)); S.st_k0 = LD8(ROW(Kp, k0, 0)); S.st_k1 = LD8(ROW(Kp, k0, 32)); } while (0)
#define SWRITE_HK(bf) do { *(ATT_LAS bf16x8*)(K_lds + (bf) * SHM_K + kws) = knorm(S.st_k0); *(ATT_LAS bf16x8*)(K_lds + (bf) * SHM_K + kws + 32 * 256) = knorm(S.st_k1); } while (0)
#define SWRITE_HV(bf) do { *(ATT_LAS bf16x8*)(V_lds + (bf) * SHM_V + vst0) = S.st_v0; *(ATT_LAS bf16x8*)(V_lds + (bf) * SHM_V + vst0 + 8192) = S.st_v1;     } while (0)
#define SWRITE_H(bf) do { SWRITE_HV(bf); SWRITE_HK(bf); } while (0)
__device__ __forceinline__ void swa_prime(const BlockRef& cur, lptr lds, Seam& S, const int tid) {
    const int wid = __builtin_amdgcn_readfirstlane(tid >> 6), lane = tid & 63, r32 = lane & 31, hi = lane >> 5;
    const int sr = tid >> 4, sc = (tid & 15) * 8, kws = KSWZ(sr, sc * 2); lptr K_lds = lds + 2 * SHM_V;
    const unsigned kvoff = (unsigned)(sr * D + sc) * 2u, qoff = (unsigned)(r32 * D + hi * 8) * 2u;
    const int kb0 = swa_jlo(cur.P0) * KVBLK;
#pragma unroll
    for (int d0 = 0; d0 < 8; ++d0) S.qr[d0] = LD8(QROWP(cur.Q, wid) + d0 * 32);
    SLOAD_H(cur.K, cur.V, kb0); VMW(); SWRITE_HK(0);
    __syncthreads();
}
__device__ __forceinline__ void swa_block(const BlockRef& cur, const BlockRef& nxt, const PhaseConst& pc, lptr lds, Seam& S, const int tid) {
    const int wid = __builtin_amdgcn_readfirstlane(tid >> 6), lane = tid & 63, r32 = lane & 31, hi = lane >> 5;
    const int j_lo = swa_jlo(cur.P0);
    int j_hi = (cur.P0 + QB - 1) / KVBLK + 1; if (j_hi > pc.skv / KVBLK) j_hi = pc.skv / KVBLK;
    const int NT = j_hi - j_lo;
    const int kbn = swa_jlo(nxt.P0) * KVBLK;
    const int qlo = cur.P0 + wid * QBLK, qm = qlo + r32 - 4 * hi;
    lptr V_lds = lds; lptr K_lds = lds + 2 * SHM_V;
    ATT_LAS float* wsc = (ATT_LAS float*)(lds + LDS_WSC) + wid * 64; ATT_LAS float* li_l = wsc; ATT_LAS float* al_l = wsc + 32;
    const ATT_LAS float* lutq = (const ATT_LAS float*)(lds + LDS_LUT + cur.lut) + (LUT_OFF - 63) + qm;
    float m_reg = -1e30f, l_reg = 0; f32x16 o[4] = {};
    const int sr = tid >> 4, sc = (tid & 15) * 8, vst0 = v_st(sr, sc), kws = KSWZ(sr, sc * 2);
    const unsigned kvoff = (unsigned)(sr * D + sc) * 2u, qoff = (unsigned)(r32 * D + hi * 8) * 2u;
    const int vb0 = (int)(unsigned)(uintptr_t)V_lds + v_rd_base(lane);
    const bf16_t* Kh = cur.K; const bf16_t* Vh = cur.V;
    q_normalize(S.qr, pc.gq, hi);
#define RESC(a) do { if (__any((a) < 1.f)) { if (hi == 0) al_l[r32] = (a); asm volatile("s_waitcnt lgkmcnt(0)" ::: "memory");              \
                     _Pragma("unroll") for (int d_ = 0; d_ < 4; ++d_) _Pragma("unroll") for (int r = 0; r < 16; ++r) o[d_][r] *= al_l[crow(r, hi)]; } } while (0)
#define KBASE(t) ((j_lo + (t)) * KVBLK)
#define ACT(t) (KBASE(t) <= qlo + QBLK - 1 && KBASE(t) + KVBLK - 1 >= qlo - W + 1)
#define MASKT(P0_, P1_, t) do { const int kb_ = KBASE(t); if (ACT(t)) { bias_tile(P0_, P1_, lutq - kb_); \
        if (kb_ + KVBLK - 1 > qlo || kb_ <= qlo + QBLK - 1 - W) mask_tile(P0_, P1_, qm - kb_, (unsigned)W); } } while (0)
    constexpr int NQL = 8;
#define SEAM_K0() do { VMWN(NQL); SWRITE_HK(0); SBAR(); } while (0)
    f32x16 pA0, pA1, pB0, pB1; float mnA, mnB, alA, alB; bf16x8 pa0, pa1, pa2, pa3;
    SWRITE_HV(0); SBAR();
    if (NT > 1) { SLOAD_H(Kh, Vh, KBASE(1)); }
    SBAR(); qkt<0>(pA0, pA1, K_lds, r32, hi, S.qr, ACT(0));
    MASKT(pA0, pA1, 0); partialSM(pA0, pA1, m_reg, mnA, alA);
    if (NT > 1) { VMW(); SWRITE_H(1); }
    __syncthreads();
#define HALF_STEP(PX0, PX1, mnX, alX, PY0, PY1, alY, t, KB, VB, SB) do {                                                      \
        SBAR(); qkt<KB>(PX0, PX1, K_lds, r32, hi, S.qr, ACT(t));                                             \
        finishSM(PY0, PY1, alY, l_reg, pa0, pa1, pa2, pa3); SBAR();                                                           \
        if ((t) + 1 < NT) { SLOAD_H(Kh, Vh, KBASE((t) + 1)); SBAR(); }                                               \
        pv_tile<VB>(o, vb0, pa0, pa1, pa2, pa3, ACT((t) - 1)); MASKT(PX0, PX1, (t)); partialSM(PX0, PX1, m_reg, mnX, alX);                                        \
        __syncthreads();                                                                                                      \
        if ((t) + 1 < NT) { VMW(); SWRITE_H(SB); }                                                                          \
        RESC(alX); __syncthreads(); } while (0)
    for (int t = 1; t + 1 < NT; t += 2) {
        HALF_STEP(pB0, pB1, mnB, alB, pA0, pA1, alA, t, 1, 0, 0);
        HALF_STEP(pA0, pA1, mnA, alA, pB0, pB1, alB, t + 1, 0, 1, 1);
    }
    const bool even = (NT & 1) == 0;
    if (even) { SBAR(); qkt<1>(pB0, pB1, K_lds, r32, hi, S.qr, ACT(NT - 1)); SBAR(); }
    SLOAD_H(nxt.K, nxt.V, kbn); SBAR();
#pragma unroll
    for (int d0 = 0; d0 < 8; ++d0) S.qr[d0] = LD8(QROWP(nxt.Q, wid) + d0 * 32);
    SBAR();
    finishSM(pA0, pA1, alA, l_reg, pa0, pa1, pa2, pa3); SBAR();
    pv_tile<0>(o, vb0, pa0, pa1, pa2, pa3, ACT(even ? NT - 2 : NT - 1));
    if (even) { MASKT(pB0, pB1, NT - 1); partialSM(pB0, pB1, m_reg, mnB, alB); __syncthreads(); RESC(alB);
        finishSM(pB0, pB1, alB, l_reg, pa0, pa1, pa2, pa3); SBAR(); pv_tile<1>(o, vb0, pa0, pa1, pa2, pa3, ACT(NT - 1)); }
    SBAR(); SEAM_K0();
    if (hi == 0) { li_l[r32] = l_reg; *(float*)((char*)(cur.LSE + (size_t)(wid * QBLK) * pc.lstr) + (unsigned)(r32 * pc.lstr) * 4u) = m_reg * (1.4426950408889634f * SCALE) + __builtin_amdgcn_logf(l_reg); }
    asm volatile("s_waitcnt lgkmcnt(0)" ::: "memory");
    float rli[16];
#pragma unroll
    for (int r = 0; r < 16; ++r) rli[r] = __builtin_amdgcn_rcpf(li_l[crow(r, hi)]);
    char* Ow = (char*)(cur.O + (size_t)(wid * QBLK) * pc.ostr) + (unsigned)(r32 * 2); const unsigned ostrb = (unsigned)pc.ostr * 2u;
#pragma unroll
    for (int r = 0; r < 16; ++r) { const int orow = crow(r, hi);
#pragma unroll
        for (int d0 = 0; d0 < 4; ++d0) { const float v = o[d0][r] * rli[r]; const float vn = __shfl_xor(v, 1);
            if ((r32 & 1) == 0) *(unsigned*)(Ow + (unsigned)orow * ostrb + d0 * 64) = cvtpk(v, vn); } }
    __syncthreads();
#undef RESC
#undef KBASE
#undef ACT
#undef MASKT
#undef SEAM_K0
#undef HALF_STEP
}
#undef ROW
#undef VMW
#undef VMWN
#undef SLOAD_H
#undef SWRITE_HK
#undef SWRITE_HV
#undef SWRITE_H
#undef LD8
#undef QROWP

struct Tensors { const bf16_t* Q; const bf16_t* K; const bf16_t* V; bf16_t* O; float* LSE; const float* lut; const float* gq; };
__device__ __forceinline__ BlockRef unit_ref(const Tensors& T, int u, int dl) {
    const int nqbl = 4 - dl, qb = u & ((1 << nqbl) - 1), t = u >> nqbl, r = t & ((1 << dl) - 1), bh = t >> dl, b = bh >> 3, h = bh & 7;
    const size_t base = ((size_t)bh * 4096 + ((size_t)r << (12 - dl))) * D;
    const size_t tok = (size_t)b * 4096 + ((size_t)(qb * QB) << dl) + r;
    BlockRef R; R.Q = T.Q + base + (size_t)qb * QB * D; R.K = T.K + base; R.V = T.V + base; R.O = T.O + tok * 1024 + h * D; R.LSE = T.LSE + tok * 8 + h; R.P0 = qb * QB; R.lut = h * LUTW * 4;
    return R;
}
__device__ __forceinline__ void attn_phase(lptr lds, const Tensors& T, int dl, int vcu, int G, int wave) {
    constexpr int NU = 512;
    const int tid = fresh_tid(wave);
    const int per = (NU + G - 1) / G, u0 = vcu * per, u1 = (u0 + per < NU) ? u0 + per : NU;
    ATT_LAS float* lut = (ATT_LAS float*)(lds + LDS_LUT);
    for (int i = tid; i < 8 * LUTW; i += NW * 64) lut[i] = T.lut[i];
    if (u0 >= u1) { __syncthreads(); return; }
    PhaseConst pc; pc.skv = 4096 >> dl; pc.ostr = 1024 << dl; pc.lstr = 8 << dl; pc.gq = T.gq;
    Seam S;
    BlockRef cur = unit_ref(T, u0, dl);
    swa_prime(cur, lds, S, tid);
    for (int u = u0; u < u1; ++u) {
        const bool last = (u + 1 >= u1);
        const BlockRef nxt = last ? cur : unit_ref(T, u + 1, dl);
        swa_block(cur, nxt, pc, lds, S, tid);
        cur = nxt;
    }
}
#undef KSWZ
#undef SBAR
}

namespace hg {
#define HG_LAS __attribute__((address_space(3)))
typedef unsigned short bf16_t;
typedef short bf16x8 __attribute__((ext_vector_type(8)));
typedef short v4i16_t __attribute__((ext_vector_type(4)));
typedef float f32x4 __attribute__((ext_vector_type(4)));
typedef unsigned u32x4 __attribute__((ext_vector_type(4)));
typedef unsigned u32x2 __attribute__((ext_vector_type(2)));
typedef HG_LAS char* lptr;
constexpr int CH = 32;
constexpr int QST = 272, KST = 288;
constexpr int OFF_QB = 0, OFF_KD = CH * QST, OFF_KE = 2 * CH * QST, OFF_V = OFF_KE + CH * KST, OFF_DEC = OFF_V + CH * KST, STAGE = OFF_DEC + 2 * 512;
constexpr int OST_ROW = 528, OSTAGE = CH * OST_ROW, OFF_OST = 2 * STAGE, LDS_BYTES = OFF_OST + 2 * OSTAGE;
constexpr float EPS = 1e-6f;
typedef float f32x2_t __attribute__((ext_vector_type(2))); typedef __bf16 bf16x2_t __attribute__((ext_vector_type(2)));
__device__ __forceinline__ unsigned cvtpk(float lo, float hi) { f32x2_t v = {lo, hi}; bf16x2_t b = __builtin_convertvector(v, bf16x2_t); return __builtin_bit_cast(unsigned, b); }
__device__ __forceinline__ u32x2 trrd(lptr p) { return __builtin_bit_cast(u32x2, __builtin_amdgcn_ds_read_tr16_b64_v4i16((HG_LAS v4i16_t*)p)); }
__device__ __forceinline__ float dpp_sum16(float v) {
    v += __builtin_bit_cast(float, __builtin_amdgcn_update_dpp(0, __builtin_bit_cast(int, v), 0xB1, 0xF, 0xF, false));
    v += __builtin_bit_cast(float, __builtin_amdgcn_update_dpp(0, __builtin_bit_cast(int, v), 0x4E, 0xF, 0xF, false));
    v += __builtin_bit_cast(float, __builtin_amdgcn_update_dpp(0, __builtin_bit_cast(int, v), 0x141, 0xF, 0xF, false));
    v += __builtin_bit_cast(float, __builtin_amdgcn_update_dpp(0, __builtin_bit_cast(int, v), 0x140, 0xF, 0xF, false));
    return v;
}
struct Tensors { const bf16_t* QB; const bf16_t* KD; const bf16_t* KE; const float* DEC; const bf16_t* V; const bf16_t* SG; const float* gn; bf16_t* OUT; };
struct Stage { u32x4 qb, kd, ke, v, dec; };
__device__ __forceinline__ void scan_seq(lptr lds, const Tensors& T, int tok0, int ntok, int h, int tid) {
    const int wid = __builtin_amdgcn_readfirstlane(tid >> 6), lane = tid & 63, c = lane & 15, g = lane >> 4;
    const int srow = tid >> 4, sc16 = tid & 15;
    const unsigned gofs = (unsigned)(srow * 2048 + h * 256 + sc16 * 16);
    const unsigned dofs = (unsigned)((tid >> 5) * 4096 + h * 512 + (tid & 31) * 16);
    const int lq = srow * QST + sc16 * 16, lk = srow * KST + sc16 * 16, ld = (tid >> 5) * 512 + (tid & 31) * 16;
    const int rq = OFF_QB + c * QST + g * 8, rkd = OFF_KD + c * QST + g * 8;
    const int rtr = (4 * g + (c >> 2)) * KST + (c & 3) * 8;
    const int rdec = OFF_DEC + g * 16;
    const int wost = (4 * g) * OST_ROW + (16 * wid + c) * 4;
    const int nrow = tid >> 4, n16 = tid & 15;
    const f32x4 gn0 = *(const f32x4*)(T.gn + 8 * n16), gn1 = *(const f32x4*)(T.gn + 8 * n16 + 4);
    f32x4 S[8];
#pragma unroll
    for (int kt = 0; kt < 8; ++kt) S[kt] = (f32x4){0.f, 0.f, 0.f, 0.f};
    Stage st;
#define HG_LOAD(tk) do { const size_t cb = (size_t)(tk) * 2048; \
        st.qb = *(const u32x4*)((const char*)T.QB + cb + gofs); st.kd = *(const u32x4*)((const char*)T.KD + cb + gofs); \
        st.ke = *(const u32x4*)((const char*)T.KE + cb + gofs); st.v = *(const u32x4*)((const char*)T.V + cb + gofs); \
        if (tid < 64) st.dec = *(const u32x4*)((const char*)T.DEC + (size_t)((tk) >> 4) * 4096 + dofs); } while (0)
#define HG_WRITE(buf) do { lptr sb_ = lds + (buf) * STAGE; \
        *(HG_LAS u32x4*)(sb_ + OFF_QB + lq) = st.qb; *(HG_LAS u32x4*)(sb_ + OFF_KD + lq) = st.kd; *(HG_LAS u32x4*)(sb_ + OFF_KE + lk) = st.ke; *(HG_LAS u32x4*)(sb_ + OFF_V + lk) = st.v; \
        if (tid < 64) *(HG_LAS u32x4*)(sb_ + OFF_DEC + ld) = st.dec; } while (0)
#define HG_NORM(tk, ob) do { const HG_LAS f32x4* op_ = (const HG_LAS f32x4*)(lds + OFF_OST + (ob) * OSTAGE + nrow * OST_ROW + n16 * 32); \
        const f32x4 a_ = op_[0], b_ = op_[1]; const size_t ro_ = ((size_t)((tk) + nrow) * 1024 + h * 128 + 8 * n16) * 2; \
        const u32x4 sg_ = *(const u32x4*)((const char*)T.SG + ro_); \
        float ss_ = (a_[0] * a_[0] + a_[1] * a_[1]) + (a_[2] * a_[2] + a_[3] * a_[3]) + (b_[0] * b_[0] + b_[1] * b_[1]) + (b_[2] * b_[2] + b_[3] * b_[3]); \
        const float rs_ = __builtin_amdgcn_rsqf(dpp_sum16(ss_) * (1.0f / 128.0f) + EPS); \
        const f32x4 x_ = a_ * gn0 * rs_, y_ = b_ * gn1 * rs_; u32x4 w_; \
        w_[0] = cvtpk(x_[0] * __builtin_bit_cast(float, sg_[0] << 16), x_[1] * __builtin_bit_cast(float, sg_[0] & 0xffff0000u)); \
        w_[1] = cvtpk(x_[2] * __builtin_bit_cast(float, sg_[1] << 16), x_[3] * __builtin_bit_cast(float, sg_[1] & 0xffff0000u)); \
        w_[2] = cvtpk(y_[0] * __builtin_bit_cast(float, sg_[2] << 16), y_[1] * __builtin_bit_cast(float, sg_[2] & 0xffff0000u)); \
        w_[3] = cvtpk(y_[2] * __builtin_bit_cast(float, sg_[3] << 16), y_[3] * __builtin_bit_cast(float, sg_[3] & 0xffff0000u)); \
        *(u32x4*)((char*)T.OUT + ro_) = w_; } while (0)
    const int nch = ntok / CH;
    HG_LOAD(tok0); HG_WRITE(0);
    __syncthreads();
    for (int ci = 0; ci < nch; ++ci) {
        const int tk = tok0 + ci * CH, buf = ci & 1;
        if (ci + 1 < nch) HG_LOAD(tk + CH);
        lptr sb = lds + buf * STAGE; lptr ob = lds + OFF_OST + buf * OSTAGE;
#pragma unroll
        for (int j = 0; j < 2; ++j) {
            bf16x8 qf[4], kf[4];
#pragma unroll
            for (int kk = 0; kk < 4; ++kk) {
                const u32x2 q0 = *(const HG_LAS u32x2*)(sb + rq + j * 16 * QST + kk * 64), q1 = *(const HG_LAS u32x2*)(sb + rq + j * 16 * QST + kk * 64 + 32);
                const u32x2 k0 = *(const HG_LAS u32x2*)(sb + rkd + j * 16 * QST + kk * 64), k1 = *(const HG_LAS u32x2*)(sb + rkd + j * 16 * QST + kk * 64 + 32);
                qf[kk] = __builtin_bit_cast(bf16x8, (u32x4){q0[0], q0[1], q1[0], q1[1]}); kf[kk] = __builtin_bit_cast(bf16x8, (u32x4){k0[0], k0[1], k1[0], k1[1]}); }
            const u32x2 vt = trrd(sb + OFF_V + rtr + j * 16 * KST + wid * 32);
            const bf16x8 vb = __builtin_bit_cast(bf16x8, (u32x4){vt[0], vt[1], 0u, 0u});
            f32x4 at = {0.f, 0.f, 0.f, 0.f};
#pragma unroll
            for (int kk = 0; kk < 4; ++kk) at = __builtin_amdgcn_mfma_f32_16x16x32_bf16(kf[kk], qf[kk], at, 0, 0, 0);
#pragma unroll
            for (int r = 0; r < 4; ++r) at[r] = (4 * g + r <= c) ? at[r] : 0.f;
            const bf16x8 pa = __builtin_bit_cast(bf16x8, (u32x4){cvtpk(at[0], at[1]), cvtpk(at[2], at[3]), 0u, 0u});
            f32x4 o = __builtin_amdgcn_mfma_f32_16x16x32_bf16(pa, vb, (f32x4){0.f, 0.f, 0.f, 0.f}, 0, 0, 0);
#pragma unroll
            for (int kk = 0; kk < 4; ++kk) {
                const bf16x8 sbf = __builtin_bit_cast(bf16x8, (u32x4){cvtpk(S[2 * kk][0], S[2 * kk][1]), cvtpk(S[2 * kk][2], S[2 * kk][3]), cvtpk(S[2 * kk + 1][0], S[2 * kk + 1][1]), cvtpk(S[2 * kk + 1][2], S[2 * kk + 1][3])});
                o = __builtin_amdgcn_mfma_f32_16x16x32_bf16(qf[kk], sbf, o, 0, 0, 0); }
#pragma unroll
            for (int r = 0; r < 4; ++r) *(HG_LAS float*)(ob + wost + (j * 16 + r) * OST_ROW) = o[r];
#pragma unroll
            for (int kt = 0; kt < 8; ++kt) {
                const f32x4 d4 = *(const HG_LAS f32x4*)(sb + rdec + j * 512 + kt * 64);
                const u32x2 kt2 = trrd(sb + OFF_KE + rtr + j * 16 * KST + kt * 32);
                const bf16x8 ka = __builtin_bit_cast(bf16x8, (u32x4){kt2[0], kt2[1], 0u, 0u});
                S[kt] = __builtin_amdgcn_mfma_f32_16x16x32_bf16(ka, vb, S[kt] * d4, 0, 0, 0); }
        }
        if (ci > 0) HG_NORM(tk - CH, buf ^ 1);
        if (ci + 1 < nch) HG_WRITE(buf ^ 1);
        __syncthreads();
    }
    HG_NORM(tok0 + (nch - 1) * CH, (nch - 1) & 1);
    __syncthreads();
#undef HG_LOAD
#undef HG_WRITE
#undef HG_NORM
}
}

constexpr int NWAVES = 8;
constexpr int NB = 4, SEQ = 4096, D = 1024, M = NB * SEQ, NH = 8, HD = 128, NG = 3, FF = 2816, NUP = 2 * FF;
constexpr float RMS_EPS = 1e-6f, ATT_SCALE = 0.08838834764831845f;
constexpr size_t MiB = 1u << 20;
constexpr size_t WS_CTL = 0, CTL_ZERO_BYTES = 1 * MiB;
constexpr size_t WS_MOD = 1 * MiB;
constexpr size_t WS_LBS = 1 * MiB + 256 * 1024;
constexpr size_t WS_LUT = 1 * MiB + 320 * 1024;
constexpr size_t WS_ML = 2 * MiB;
constexpr size_t WS_LUT2 = 1 * MiB + 384 * 1024;
constexpr size_t WS_GQ = 1 * MiB + 448 * 1024;
constexpr size_t WS_WQKV = 8 * MiB, WS_WO = 26 * MiB, WS_W13_0 = 28 * MiB, WS_W2_0 = 39 * MiB;
constexpr size_t WS_WIN = 44 * MiB + 512 * 1024, WS_WHO = WS_WIN + 8 * MiB, WS_W13_1 = WS_WHO + 2 * MiB, WS_W2_1 = WS_W13_1 + 11 * MiB;
constexpr size_t WS_SG = 8 * MiB;
constexpr size_t WS_ACT = 72 * MiB;
constexpr size_t WS_BIG = 104 * MiB;
constexpr size_t WS_R2 = 200 * MiB;
constexpr size_t WS_END = 256 * MiB;
constexpr size_t QKV_STRIDE = (size_t)NB * NH * SEQ * HD;
constexpr int LUT_N = 129;
constexpr int CW_BAR = 4096;
constexpr int RING_BYTES = 131072, LDSCTL_OFF = RING_BYTES, MISC_OFF = LDSCTL_OFF + 320, LDS_BYTES = 147456;

struct Args { const float* in[18]; float* out; unsigned char* ws; int ph_lo, ph_hi; };
struct Frame {
    LAS unsigned char* lds; volatile LAS unsigned* MISC; gu32* ctl;
    int wave, vcu, G;
};

typedef const __attribute__((address_space(4))) Args* kargs_t;
__device__ __forceinline__ kargs_t kargs() { kargs_t p = (kargs_t)__builtin_amdgcn_kernarg_segment_ptr(); asm volatile("" : "+s"(p)); return p; }
__device__ __forceinline__ float bf2f(unsigned short h) { return __builtin_bit_cast(float, (unsigned)h << 16); }
__device__ __forceinline__ float bflo(unsigned w) { return __builtin_bit_cast(float, w << 16); }
__device__ __forceinline__ float bfhi(unsigned w) { return __builtin_bit_cast(float, w & 0xffff0000u); }
__device__ __forceinline__ float wave_sum(float v) {
#pragma unroll
    for (int o = 1; o < 64; o <<= 1) v += __shfl_xor(v, o);
    return v;
}
__device__ __forceinline__ void tr_item(const float* W, int Nsrc, int K, bf16* WT, int k0, int n0s, int drow0, LAS float* scr, int lane) {
#pragma unroll 8
    for (int i = 0; i < 32; ++i) { const int kk = 2 * i + (lane >> 5); scr[kk * 33 + (lane & 31)] = W[(size_t)(k0 + kk) * Nsrc + n0s + (lane & 31)]; }
    LDS_WAIT(); asm volatile("" ::: "memory");
    const int c = lane & 7;
#pragma unroll
    for (int j = 0; j < 4; ++j) { const int n = (lane >> 3) + 8 * j; const LAS float* s = scr + (8 * c) * 33 + n;
        v4u o; o.x = pk2(s[0 * 33], s[1 * 33]); o.y = pk2(s[2 * 33], s[3 * 33]); o.z = pk2(s[4 * 33], s[5 * 33]); o.w = pk2(s[6 * 33], s[7 * 33]);
        *(GAS v4u*)(WT + (size_t)(drow0 + n) * K + k0 + 8 * c) = o; }
    LDS_WAIT(); asm volatile("" ::: "memory");
}
__device__ __forceinline__ int t5_bucket(int n) {
    if (n < 16) return n;
    int v = 16 + (int)(log((double)n / 16.0) / log(128.0) * 16.0);
    return v > 31 ? 31 : v;
}
__device__ __forceinline__ void p0_prologue(Frame& F) {
    const int ptid = fresh_tid(F.wave), plane = ptid & 63;
    const kargs_t A = kargs(); unsigned char* const ws = A->ws;
    if (F.vcu < 48) {
        LAS float* cact = (LAS float*)F.lds;
        LAS float* red = (LAS float*)(F.lds + 16384);
        for (int i = ptid; i < 4096; i += NWAVES * 64) { const float c = A->in[1][i]; cact[i] = c * __builtin_amdgcn_rcpf(1.0f + __expf(-c)); }
        __syncthreads();
        const int l = F.vcu / 24, cg = F.vcu % 24;
        const float* wp = A->in[3] + (size_t)l * 1024 * 6144 + (size_t)(F.wave * 128) * 6144 + cg * 256 + plane * 4;
        f32x4 a0 = {0.f, 0.f, 0.f, 0.f}, a1 = a0, a2 = a0, a3 = a0;
#pragma unroll 8
        for (int k = 0; k < 128; ++k) { const f32x4 wv = *(const f32x4*)(wp + (size_t)k * 6144); const int kk = F.wave * 128 + k;
            a0 += wv * cact[kk]; a1 += wv * cact[1024 + kk]; a2 += wv * cact[2048 + kk]; a3 += wv * cact[3072 + kk]; }
        LAS f32x4* r4 = (LAS f32x4*)red + F.wave * 256;
        r4[plane] = a0; r4[64 + plane] = a1; r4[128 + plane] = a2; r4[192 + plane] = a3;
        __syncthreads();
        float* mod = (float*)(ws + WS_MOD);
        for (int idx = ptid; idx < 1024; idx += NWAVES * 64) { const int b = idx >> 8, col = idx & 255; float s = 0.f;
#pragma unroll
            for (int w = 0; w < 8; ++w) s += red[(w * 4 + b) * 256 + col];
            mod[(size_t)(l * 4 + b) * 6144 + cg * 256 + col] = s + A->in[4][l * 6144 + cg * 256 + col]; }
        __syncthreads();
    } else if (F.vcu == 48) {
        float* lbs = (float*)(ws + WS_LBS);
        for (int k = ptid; k < 1024; k += NWAVES * 64) { const float b0 = A->in[14][k], b1 = A->in[14][1024 + k]; lbs[k] = 1.0f / (1.0f + expf(b0 - b1)); }
    } else if (F.vcu == 49) {
        float* lut = (float*)(ws + WS_LUT);
        for (int i = ptid; i < NG * NH * LUT_N; i += NWAVES * 64) { const int j = i % LUT_N, gh = i / LUT_N, g = gh >> 3;
            lut[i] = A->in[2][t5_bucket(j << (2 * g)) * (NG * NH) + gh]; }
        float* lut2 = (float*)(ws + WS_LUT2);
        for (int i = ptid; i < NG * NH * att::LUTW; i += NWAVES * 64) { const int j = i % att::LUTW - att::LUT_OFF, gh = i / att::LUTW, g = gh >> 3;
            lut2[i] = (j >= 0 && j <= 128) ? A->in[2][t5_bucket(j << (2 * g)) * (NG * NH) + gh] * (1.0f / ATT_SCALE) : 0.f; }
        float* gq = (float*)(ws + WS_GQ);
        for (int i = ptid; i < NG * 128; i += NWAVES * 64) gq[i] = A->in[9][i] * A->in[10][i];
    }
    LAS float* scr = (LAS float*)(F.lds + F.wave * 16384);
    const int gw = F.vcu * NWAVES + F.wave, NGW = F.G * NWAVES;
    constexpr int I_QKV = 16 * 288, I_SQ = 16 * 32, I_UP = 16 * 88, I_DN = 44 * 32, I_IN = 16 * 128;
    constexpr int NITEMS = I_QKV + I_SQ + 2 * I_UP + I_DN + I_IN + I_SQ + 2 * I_UP + I_DN;
    for (int it = gw; it < NITEMS; it += NGW) {
        int r = it;
        if (r < I_QKV) { const int kb = r / 288, nb = r % 288; tr_item(A->in[7], 9216, 1024, (bf16*)(ws + WS_WQKV), 64 * kb, 32 * nb, 32 * nb, scr, plane); continue; } r -= I_QKV;
        if (r < I_SQ) { const int kb = r / 32, nb = r % 32; tr_item(A->in[8], 1024, 1024, (bf16*)(ws + WS_WO), 64 * kb, 32 * nb, 32 * nb, scr, plane); continue; } r -= I_SQ;
        if (r < I_IN) { const int kb = r / 128, nb = r % 128;
            const int seg = nb >> 5, hh = (nb >> 2) & 7, sub = nb & 3;
            tr_item(A->in[11], 4096, 1024, (bf16*)(ws + WS_WIN), 64 * kb, 32 * nb, 256 * (2 * hh + (seg >> 1)) + 128 * (seg & 1) + 32 * sub, scr, plane); continue; } r -= I_IN;
        if (r < I_SQ) { const int kb = r / 32, nb = r % 32; tr_item(A->in[12], 1024, 1024, (bf16*)(ws + WS_WHO), 64 * kb, 32 * nb, 32 * nb, scr, plane); continue; } r -= I_SQ;
        const int l = r / (2 * I_UP + I_DN); r -= l * (2 * I_UP + I_DN);
        if (r < 2 * I_UP) { const int which = r / I_UP, rr = r % I_UP, kb = rr / 88, nb = rr % 88;
            tr_item((which ? A->in[16] : A->in[15]) + (size_t)l * 1024 * FF, FF, 1024, (bf16*)(ws + (l ? WS_W13_1 : WS_W13_0)), 64 * kb, 32 * nb, 256 * (nb >> 2) + 128 * which + 32 * (nb & 3), scr, plane); continue; } r -= 2 * I_UP;
        { const int kb = r / 32, nb = r % 32; tr_item(A->in[17] + (size_t)l * FF * 1024, 1024, FF, (bf16*)(ws + (l ? WS_W2_1 : WS_W2_0)), 64 * kb, 32 * nb, 32 * nb, scr, plane); }
    }
}
__device__ __forceinline__ void norm_mod_pass(Frame& F, const float* x, const float* gain, const float* sh, const float* sc) {
    const int ptid = fresh_tid(F.wave), plane = ptid & 63;
    unsigned char* const ws = kargs()->ws;
    const int gw = F.vcu * NWAVES + F.wave, NGW = F.G * NWAVES;
    bf16* act = (bf16*)(ws + WS_ACT);
    for (int r0 = gw * 8; r0 < M; r0 += NGW * 8) {
        const int b = r0 >> 12;
        f32x4 gam[4], shv[4];
#pragma unroll
        for (int j = 0; j < 4; ++j) { const int c = 4 * plane + 256 * j; const f32x4 gn = *(const f32x4*)(gain + c), s = *(const f32x4*)(sc + b * 6144 + c);
            gam[j] = gn * (s + 1.0f); shv[j] = *(const f32x4*)(sh + b * 6144 + c); }
#pragma unroll 1
        for (int rr = 0; rr < 8; rr += 2) {
            f32x4 v[2][4];
#pragma unroll
            for (int q = 0; q < 2; ++q)
#pragma unroll
                for (int j = 0; j < 4; ++j) v[q][j] = *(const GAS f32x4*)(x + (size_t)(r0 + rr + q) * D + 4 * plane + 256 * j);
#pragma unroll
            for (int q = 0; q < 2; ++q) { float s = 0.f;
#pragma unroll
                for (int j = 0; j < 4; ++j) s += (v[q][j].x * v[q][j].x + v[q][j].y * v[q][j].y) + (v[q][j].z * v[q][j].z + v[q][j].w * v[q][j].w);
                const float rstd = 1.0f / sqrtf(wave_sum(s) * (1.0f / D) + RMS_EPS);
                GAS unsigned long long* o8 = (GAS unsigned long long*)(act + (size_t)(r0 + rr + q) * D) + plane;
#pragma unroll
                for (int j = 0; j < 4; ++j) { const f32x4 o = v[q][j] * rstd * gam[j] + shv[j];
                    o8[64 * j] = (unsigned long long)pk2(o.x, o.y) | ((unsigned long long)pk2(o.z, o.w) << 32); } }
        }
    }
}
__device__ __forceinline__ void attn_naive(Frame& F, int g) {
    const int ptid = fresh_tid(F.wave), plane = ptid & 63;
    const kargs_t A = kargs(); unsigned char* const ws = A->ws; float* const outp = A->out;
    const int dl = 2 * g, dmask = (1 << dl) - 1, Lsub = SEQ >> dl;
    const bf16* Q = (const bf16*)(ws + WS_BIG); const bf16* K = Q + QKV_STRIDE; const bf16* V = K + QKV_STRIDE;
    float* ML = (float*)(ws + WS_ML); float* orun = outp; bf16* act = (bf16*)(ws + WS_ACT);
    const float* lut = (const float*)(ws + WS_LUT);
    const int l2 = 2 * plane;
    const float qk0 = A->in[9][g * 128 + l2] * A->in[10][g * 128 + l2], qk1 = A->in[9][g * 128 + l2 + 1] * A->in[10][g * 128 + l2 + 1];
    const int gw = F.vcu * NWAVES + F.wave, NGW = F.G * NWAVES;
    for (int item = gw; item < M * NH; item += NGW) {
        const int row = item >> 3, h = item & 7, b = row >> 12, t = row & 4095, r = t & dmask, mi = t >> dl;
        const size_t hb = ((size_t)(b * 8 + h) * SEQ + (size_t)r * Lsub) * HD;
        const unsigned qw = *(const GAS unsigned*)(Q + hb + (size_t)mi * HD + l2);
        float q0 = bflo(qw), q1 = bfhi(qw);
        const float rq = 1.0f / sqrtf(wave_sum(q0 * q0 + q1 * q1) * (1.0f / HD) + RMS_EPS);
        q0 *= rq * qk0; q1 *= rq * qk1;
        float m = -1e30f, l = 0.f, o0 = 0.f, o1 = 0.f;
        if (g > 0) { m = ML[(size_t)item * 2]; l = ML[(size_t)item * 2 + 1]; o0 = orun[(size_t)row * D + h * HD + l2]; o1 = orun[(size_t)row * D + h * HD + l2 + 1]; }
        const float* bl = lut + (g * 8 + h) * LUT_N;
        const int nj = mi < 128 ? mi : 128;
        for (int j = 0; j <= nj; ++j) {
            const size_t ko = hb + (size_t)(mi - j) * HD + l2;
            const unsigned kw = *(const GAS unsigned*)(K + ko), vw = *(const GAS unsigned*)(V + ko);
            const float k0 = bflo(kw), k1 = bfhi(kw);
            float a = q0 * k0 + q1 * k1, s2 = k0 * k0 + k1 * k1;
#pragma unroll
            for (int o = 1; o < 64; o <<= 1) { a += __shfl_xor(a, o); s2 += __shfl_xor(s2, o); }
            const float s = a * (1.0f / sqrtf(s2 * (1.0f / HD) + RMS_EPS)) * ATT_SCALE + bl[j];
            const float mn = fmaxf(m, s), al = __expf(m - mn), p = __expf(s - mn);
            l = l * al + p; o0 = o0 * al + p * bflo(vw); o1 = o1 * al + p * bfhi(vw); m = mn;
        }
        if (g < 2) { if (plane == 0) { ML[(size_t)item * 2] = m; ML[(size_t)item * 2 + 1] = l; }
            orun[(size_t)row * D + h * HD + l2] = o0; orun[(size_t)row * D + h * HD + l2 + 1] = o1; }
        else { const float il = 1.0f / l; *(GAS unsigned*)(act + (size_t)row * D + h * HD + l2) = pk2(o0 * il, o1 * il); }
    }
}
__device__ __forceinline__ void merge_pass(Frame& F) {
    const int ptid = fresh_tid(F.wave), plane = ptid & 63;
    const kargs_t A = kargs(); unsigned char* const ws = A->ws;
    const bf16* O0 = (const bf16*)A->out; const bf16* O1 = O0 + (size_t)M * D; const bf16* O2 = (const bf16*)(ws + WS_R2);
    const float* L = (const float*)(ws + WS_ML); bf16* act = (bf16*)(ws + WS_ACT);
    const int gw = F.vcu * NWAVES + F.wave, NGW = F.G * NWAVES, head = plane >> 3;
    for (int r0 = gw * 8; r0 < M; r0 += NGW * 8) {
#pragma unroll 2
        for (int rr = 0; rr < 8; ++rr) { const size_t row = (size_t)(r0 + rr), off = row * D + 16 * plane;
            const float l0 = L[row * 8 + head], l1 = L[(size_t)M * 8 + row * 8 + head], l2 = L[(size_t)2 * M * 8 + row * 8 + head];
            const v4u a0 = *(const GAS v4u*)(O0 + off), a1 = *(const GAS v4u*)(O0 + off + 8), b0 = *(const GAS v4u*)(O1 + off), b1 = *(const GAS v4u*)(O1 + off + 8), c0 = *(const GAS v4u*)(O2 + off), c1 = *(const GAS v4u*)(O2 + off + 8);
            const float mx = fmaxf(l0, fmaxf(l1, l2));
            float w0 = __builtin_amdgcn_exp2f(l0 - mx), w1 = __builtin_amdgcn_exp2f(l1 - mx), w2 = __builtin_amdgcn_exp2f(l2 - mx);
            const float inv = 1.0f / (w0 + w1 + w2); w0 *= inv; w1 *= inv; w2 *= inv;
            v4u o0, o1;
#pragma unroll
            for (int i = 0; i < 4; ++i) {
                o0[i] = pk2(w0 * bflo(a0[i]) + w1 * bflo(b0[i]) + w2 * bflo(c0[i]), w0 * bfhi(a0[i]) + w1 * bfhi(b0[i]) + w2 * bfhi(c0[i]));
                o1[i] = pk2(w0 * bflo(a1[i]) + w1 * bflo(b1[i]) + w2 * bflo(c1[i]), w0 * bfhi(a1[i]) + w1 * bfhi(b1[i]) + w2 * bfhi(c1[i])); }
            *(GAS v4u*)(act + off) = o0; *(GAS v4u*)(act + off + 8) = o1; }
    }
}
__device__ __forceinline__ void hgrn_naive(Frame& F) {
    const int ptid = fresh_tid(F.wave), plane = ptid & 63;
    if (F.vcu >= NB * NH) return;
    const kargs_t A = kargs(); unsigned char* const ws = A->ws;
    const int b = F.vcu >> 3, h = F.vcu & 7, kq = F.wave >> 1, v = 64 * (F.wave & 1) + plane;
    const bf16* QS = (const bf16*)(ws + WS_BIG); const float* FG = (const float*)(ws + WS_BIG + 32 * MiB);
    const bf16* V = (const bf16*)(ws + WS_R2); const bf16* SG = (const bf16*)(ws + WS_SG); bf16* act = (bf16*)(ws + WS_ACT);
    LAS float* po = (LAS float*)F.lds;
    float S[32];
#pragma unroll
    for (int j = 0; j < 32; ++j) S[j] = 0.f;
    const int tt2 = ptid >> 5, l32 = ptid & 31;
    const f32x4 gn = *(const f32x4*)(A->in[13] + 4 * l32);
    for (int t0 = 0; t0 < SEQ; t0 += 16) {
        for (int tt = 0; tt < 16; ++tt) {
            const size_t ro = (size_t)(b * SEQ + t0 + tt) * D + h * HD;
            const float iv = bf2f(V[ro + v]);
            const float* fgp = FG + ro + 32 * kq; const bf16* qp = QS + ro + 32 * kq;
            float acc = 0.f;
#pragma unroll
            for (int j4 = 0; j4 < 8; ++j4) { const f32x4 f4 = *(const f32x4*)(fgp + 4 * j4); const unsigned long long q4 = *(const unsigned long long*)(qp + 4 * j4);
#pragma unroll
                for (int i = 0; i < 4; ++i) { const float fg = f4[i], qv = bf2f((unsigned short)(q4 >> (16 * i)));
                    S[4 * j4 + i] = fg * S[4 * j4 + i] + (1.0f - fg) * iv; acc += qv * S[4 * j4 + i]; } }
            po[(tt * 4 + kq) * 128 + v] = acc;
        }
        __syncthreads();
        { const size_t ro = (size_t)(b * SEQ + t0 + tt2) * D + h * HD + 4 * l32;
          const LAS f32x4* p4 = (const LAS f32x4*)po + (tt2 * 4) * 32 + l32;
          const f32x4 o = (p4[0] + p4[32]) + (p4[64] + p4[96]);
          float ss = (o.x * o.x + o.y * o.y) + (o.z * o.z + o.w * o.w);
#pragma unroll
          for (int sft = 1; sft < 32; sft <<= 1) ss += __shfl_xor(ss, sft);
          const float rstd = 1.0f / sqrtf(ss * (1.0f / HD) + RMS_EPS);
          const unsigned long long sg = *(const unsigned long long*)(SG + ro);
          const f32x4 r = o * rstd * gn;
          const unsigned lo = pk2(r.x * bf2f((unsigned short)sg), r.y * bf2f((unsigned short)(sg >> 16))), hi = pk2(r.z * bf2f((unsigned short)(sg >> 32)), r.w * bf2f((unsigned short)(sg >> 48)));
          *(GAS unsigned long long*)(act + ro) = (unsigned long long)lo | ((unsigned long long)hi << 32); }
        __syncthreads();
    }
}

constexpr int NPHASE = 20;
#ifndef NAIVE_ATTN
#define NAIVE_ATTN 0
#endif
#ifndef NAIVE_HGRN
#define NAIVE_HGRN 0
#endif
__global__ void __launch_bounds__(NWAVES * 64, 2) mk_fwd(Args args) {
    extern __shared__ __attribute__((aligned(16))) unsigned char lds[];
    Frame F;
    F.lds = (LAS unsigned char*)lds; F.MISC = (volatile LAS unsigned*)(F.lds + MISC_OFF);
    F.wave = __builtin_amdgcn_readfirstlane((int)threadIdx.x >> 6);
    F.G = gridDim.x; { const int bx = blockIdx.x; F.vcu = (F.G % 8 == 0) ? (bx % 8) * (F.G / 8) + bx / 8 : bx; }
    F.ctl = (gu32*)(args.ws + WS_CTL);
    for (int u = fresh_tid(F.wave); u < (LDS_BYTES - LDSCTL_OFF) / 4; u += NWAVES * 64) ((LAS unsigned*)(F.lds + LDSCTL_OFF))[u] = 0u;
    __syncthreads();
    const int lo = args.ph_lo, hi = args.ph_hi;
    const bool multi = (hi - lo) > 1;
    XcdBarrier bar; bar.bar = (unsigned*)(F.ctl + CW_BAR); bar.x = 0; bar.st = nullptr; bar.wave = F.wave;
    if (multi) bar = xcd_barrier_post((unsigned*)(F.ctl + CW_BAR), F.MISC + 8, F.wave);
#ifndef PH_MASK
#define PH_MASK 0xFFFFFFFFu
#endif
#define IN(k) (((PH_MASK >> (k)) & 1u) && lo <= (k) && (k) < hi)
#define SEAM(k) do { if (IN(k) && IN((k) + 1)) xcd_barrier(bar); } while (0)
#define PHASE_PTRS const kargs_t A = kargs(); unsigned char* const ws = A->ws; float* const outp = A->out; float* const mod = (float*)(ws + WS_MOD); bf16* const act = (bf16*)(ws + WS_ACT); (void)outp; (void)mod; (void)act
    enum { P_PRO = 0, P_XN0 = 1, P_QKV = 2  , P_ATT = 3  , P_MRG = 8, P_WO = 9, P_XNF0 = 10, P_UP0 = 11, P_DN0 = 12, P_XN1 = 13, P_HIN = 14, P_SCAN = 15, P_HOUT = 16, P_XNF1 = 17, P_UP1 = 18, P_DN1 = 19 };
    if (IN(P_PRO)) { p0_prologue(F); } SEAM(P_PRO);
    if (IN(P_XN0)) { PHASE_PTRS; norm_mod_pass(F, A->in[0], A->in[5], mod + 0, mod + 1024); } SEAM(P_XN0);
#if NAIVE_ATTN
#define ATT_GROUP(g) if (IN(P_ATT + 2 * (g))) { attn_naive(F, (g)); } SEAM(P_ATT + 2 * (g));
#else
#define ATT_GROUP(g) if (IN(P_ATT + 2 * (g))) { PHASE_PTRS; \
            att::Tensors T; T.Q = (const bf16*)(ws + WS_BIG); T.K = T.Q + QKV_STRIDE; T.V = T.K + QKV_STRIDE; \
            T.O = (g) == 2 ? (bf16*)(ws + WS_R2) : (bf16*)outp + (size_t)(g) * M * D; T.LSE = (float*)(ws + WS_ML) + (size_t)(g) * M * 8; \
            T.lut = (const float*)(ws + WS_LUT2) + (g) * 8 * att::LUTW; T.gq = (const float*)(ws + WS_GQ) + (g) * 128; \
            att::attn_phase((att::lptr)F.lds, T, 2 * (g), F.vcu, F.G, F.wave); \
        } SEAM(P_ATT + 2 * (g));
#endif
#define QKV_GROUP(g) if (IN(P_QKV + 2 * (g))) { PHASE_PTRS; \
            pg8::Gemm gm{act, (const bf16*)(ws + WS_WQKV) + (size_t)(g) * 3072 * 1024, M, 3072, 1024}; pg8::StaticOrder S; S.init(M, 3072, F.G, (int)blockIdx.x); \
            pg8::EpiQKV E{(bf16*)(ws + WS_BIG), 2 * (g)}; \
            pg8::gemm_phase<pg8::EpiQKV, pg8::StaticOrder, true, true>(F.lds, gm, S, E, F.wave); \
        } SEAM(P_QKV + 2 * (g));
    QKV_GROUP(0) ATT_GROUP(0) QKV_GROUP(1) ATT_GROUP(1) QKV_GROUP(2) ATT_GROUP(2)
#if !NAIVE_ATTN
    if (IN(P_MRG)) { merge_pass(F); }
#endif
    SEAM(P_MRG);
    if (IN(P_WO)) { PHASE_PTRS;
        pg8::Gemm gm{act, (const bf16*)(ws + WS_WO), M, 1024, 1024}; pg8::StaticOrder S; S.init(M, 1024, F.G, (int)blockIdx.x);
        pg8::EpiRes E{A->in[0], outp, mod + 2048};
        pg8::gemm_phase<pg8::EpiRes, pg8::StaticOrder, true, true>(F.lds, gm, S, E, F.wave);
    } SEAM(P_WO);
#define FFN_LAYER(l, p0) \
        if (IN(p0)) { PHASE_PTRS; float* const modl = mod + (size_t)(l) * 4 * 6144; norm_mod_pass(F, outp, A->in[6] + (l) * 1024, modl + 3072, modl + 4096); } SEAM(p0); \
        if (IN((p0) + 1)) { PHASE_PTRS; \
            pg8::Gemm gm{act, (const bf16*)(ws + ((l) ? WS_W13_1 : WS_W13_0)), M, NUP, 1024}; pg8::StaticOrder S; S.init(M, NUP, F.G, (int)blockIdx.x); \
            pg8::EpiSwiGLU E{(bf16*)(ws + WS_BIG), FF}; \
            pg8::gemm_phase<pg8::EpiSwiGLU, pg8::StaticOrder, true, true>(F.lds, gm, S, E, F.wave); \
        } SEAM((p0) + 1); \
        if (IN((p0) + 2)) { PHASE_PTRS; float* const modl = mod + (size_t)(l) * 4 * 6144; \
            pg8::Gemm gm{(const bf16*)(ws + WS_BIG), (const bf16*)(ws + ((l) ? WS_W2_1 : WS_W2_0)), M, 1024, FF}; pg8::StaticOrder S; S.init(M, 1024, F.G, (int)blockIdx.x); \
            pg8::EpiRes E{outp, outp, modl + 5120}; \
            pg8::gemm_phase<pg8::EpiRes, pg8::StaticOrder, true, true>(F.lds, gm, S, E, F.wave); \
        } SEAM((p0) + 2);
    FFN_LAYER(0, P_XNF0)
    if (IN(P_XN1)) { PHASE_PTRS; float* const mod1 = mod + (size_t)4 * 6144; norm_mod_pass(F, outp, A->in[5] + 1024, mod1 + 0, mod1 + 1024); } SEAM(P_XN1);
    if (IN(P_HIN)) { PHASE_PTRS;
        pg8::Gemm gm{act, (const bf16*)(ws + WS_WIN), M, 4096, 1024}; pg8::StaticOrder S; S.init(M, 4096, F.G, (int)blockIdx.x);
#if NAIVE_HGRN
        pg8::EpiHgrnNaive E{(bf16*)(ws + WS_BIG), (float*)(ws + WS_BIG + 32 * MiB), (bf16*)(ws + WS_R2), (bf16*)(ws + WS_SG), (const float*)(ws + WS_LBS)};
        pg8::gemm_phase<pg8::EpiHgrnNaive, pg8::StaticOrder, true, true>(F.lds, gm, S, E, F.wave);
#else
        pg8::EpiHgrn E{(bf16*)(ws + WS_BIG), (bf16*)(ws + WS_BIG + 32 * MiB), (bf16*)(ws + WS_BIG + 64 * MiB), (float*)(ws + WS_R2 + 32 * MiB), (bf16*)(ws + WS_R2), (bf16*)(ws + WS_SG), (const float*)(ws + WS_LBS)};
        pg8::gemm_phase<pg8::EpiHgrn, pg8::StaticOrder, true, true>(F.lds, gm, S, E, F.wave);
#endif
    } SEAM(P_HIN);
#if NAIVE_HGRN
    if (IN(P_SCAN)) { hgrn_naive(F); } SEAM(P_SCAN);
#else
    if (IN(P_SCAN)) { PHASE_PTRS;
        if (F.vcu < NB * NH) {
            hg::Tensors T; T.QB = (const bf16*)(ws + WS_BIG); T.KD = (const bf16*)(ws + WS_BIG + 32 * MiB); T.KE = (const bf16*)(ws + WS_BIG + 64 * MiB); T.DEC = (const float*)(ws + WS_R2 + 32 * MiB);
            T.V = (const bf16*)(ws + WS_R2); T.SG = (const bf16*)(ws + WS_SG); T.gn = A->in[13]; T.OUT = act;
            hg::scan_seq((hg::lptr)F.lds, T, (F.vcu >> 3) * SEQ, SEQ, F.vcu & 7, fresh_tid(F.wave));
        }
    } SEAM(P_SCAN);
#endif
    if (IN(P_HOUT)) { PHASE_PTRS; float* const mod1 = mod + (size_t)4 * 6144;
        pg8::Gemm gm{act, (const bf16*)(ws + WS_WHO), M, 1024, 1024}; pg8::StaticOrder S; S.init(M, 1024, F.G, (int)blockIdx.x);
        pg8::EpiRes E{outp, outp, mod1 + 2048};
        pg8::gemm_phase<pg8::EpiRes, pg8::StaticOrder, true, true>(F.lds, gm, S, E, F.wave);
    } SEAM(P_HOUT);
    FFN_LAYER(1, P_XNF1)
#undef IN
#undef SEAM
}

#ifndef MK_PER_PHASE
#define MK_PER_PHASE 0
#endif
extern "C" void kernel_launch(void* const* d_in, const int* in_sizes, int n_in, void* d_out, int out_size, void* d_ws, size_t ws_size, hipStream_t stream) {
    static int grid = 0;
    if (grid == 0) {
        if (n_in != 18 || in_sizes[0] != M * D || out_size != M * D || ws_size < WS_END) { fprintf(stderr, "kernel_launch: unexpected shapes (n_in %d, in0 %d, out %d, ws %zu); nothing launched\n", n_in, n_in > 0 ? in_sizes[0] : -1, out_size, ws_size); grid = -1; return; }
        int dev = 0, cus = 0, per_cu = 0;
        if (hipGetDevice(&dev) != hipSuccess || hipDeviceGetAttribute(&cus, hipDeviceAttributeMultiprocessorCount, dev) != hipSuccess) { grid = -1; return; }
        if (hipFuncSetAttribute((const void*)mk_fwd, hipFuncAttributeMaxDynamicSharedMemorySize, LDS_BYTES) != hipSuccess) { fprintf(stderr, "kernel_launch: hipFuncSetAttribute failed\n"); grid = -1; return; }
        if (hipOccupancyMaxActiveBlocksPerMultiprocessor(&per_cu, (const void*)mk_fwd, NWAVES * 64, LDS_BYTES) != hipSuccess || per_cu < 1) { fprintf(stderr, "kernel_launch: occupancy query says %d blocks per CU\n", per_cu); (void)hipGetLastError(); grid = -1; return; }
        grid = cus;
    }
    if (grid < 0) return;
    if (hipMemsetAsync((char*)d_ws + WS_CTL, 0, CTL_ZERO_BYTES, stream) != hipSuccess) return;
    Args a{};
    for (int i = 0; i < 18; ++i) a.in[i] = (const float*)d_in[i];
    a.out = (float*)d_out; a.ws = (unsigned char*)d_ws;
#if MK_PER_PHASE
    for (int p = 0; p < NPHASE; ++p) { a.ph_lo = p; a.ph_hi = p + 1; hipLaunchKernelGGL(mk_fwd, dim3(grid), dim3(NWAVES * 64), LDS_BYTES, stream, a); }
#else
    a.ph_lo = 0; a.ph_hi = NPHASE; hipLaunchKernelGGL(mk_fwd, dim3(grid), dim3(NWAVES * 64), LDS_BYTES, stream, a);
#endif
}
```

```cpp
#include <hip/hip_runtime.h>
#include <cstdio>
#include <cstdint>
#include <cmath>

__device__ __forceinline__ int fresh_lane() { unsigned z = 0u; asm volatile("" : "+s"(z)); return (int)__builtin_amdgcn_mbcnt_hi(~0u, __builtin_amdgcn_mbcnt_lo(~0u, z)); }
__device__ __forceinline__ int fresh_tid(int wave) { return wave * 64 + fresh_lane(); }

namespace pg8 {
#define PG8_LAS __attribute__((address_space(3)))
typedef unsigned short bf16_t;
typedef short bf16x8 __attribute__((ext_vector_type(8)));
typedef float f32x4 __attribute__((ext_vector_type(4)));
typedef unsigned u32x4 __attribute__((ext_vector_type(4)));
constexpr int BM = 256, BK = 64, HALF = 128, HTB = HALF * BK * 2  , STAGE_BYTES = 8 * HTB, NXCD = 8, WGM = 8;

__host__ __device__ __forceinline__ int lds_byte(int r, int c) { const int st = (r >> 4) * 2 + (c >> 5), rr = r & 15, cc = c & 31, ob = rr * 64 + cc * 2; return st * 1024 + (ob ^ (((ob >> 9) & 1) << 5)); }
__host__ __device__ __forceinline__ void stage_rc(int b, int& R, int& C) { const int st = b / 1024, sb = b % 1024, swz = sb ^ (((sb >> 9) & 1) << 5); R = (st >> 1) * 16 + swz / 64; C = (st & 1) * 32 + (swz % 64) / 2; }
__host__ __device__ __forceinline__ int perm32(int rho) { const int n = rho >> 4, i = rho & 15; return 8 * (i >> 2) + 4 * n + (i & 3); }

struct Unit { int pm, pn; };
struct Gemm { const bf16_t* A; const bf16_t* Bt; int M, N, K; };

struct StaticOrder {
    int nM, nN, nwg, G, c;
    __host__ __device__ void init(int M, int N, int G_, int c_) { nM = M / BM; nN = N / BM; nwg = nM * nN; G = G_; c = c_; }
    __host__ __device__ bool next(int i, Unit& u) const {
        const long L = (long)i * G + c; if (L >= nwg) return false;
        int wgid = (int)L; { const int q = nwg / NXCD, r = nwg % NXCD, xcd = wgid % NXCD, off = wgid / NXCD; wgid = (xcd < r ? xcd * (q + 1) : r * (q + 1) + (xcd - r) * q) + off; }
        const int nig = WGM * nN, gid = wgid / nig, fm = gid * WGM, gsz = (nM - fm) < WGM ? (nM - fm) : WGM;
        u.pm = fm + ((wgid % nig) % gsz); u.pn = (wgid % nig) / gsz; return true;
    }
    __device__ __forceinline__ void a_ready(const Unit&) const {}
    __device__ __forceinline__ void done(const Unit&) const {}
};


__device__ __forceinline__ unsigned cvt_pk_bf16(float lo, float hi) { unsigned r; asm volatile("v_cvt_pk_bf16_f32 %0, %1, %2" : "=v"(r) : "v"(lo), "v"(hi)); return r; }
__device__ __forceinline__ float silu_f(float a) { return a * __builtin_amdgcn_rcpf(1.0f + __expf(-a)); }
__device__ __forceinline__ float sigmoid_f(float a) { return __builtin_amdgcn_rcpf(1.0f + __expf(-a)); }
__device__ __forceinline__ u32x4 pack8(const f32x4 a, const f32x4 b) { u32x4 w; w.x = cvt_pk_bf16(a[0], a[1]); w.y = cvt_pk_bf16(a[2], a[3]); w.z = cvt_pk_bf16(b[0], b[1]); w.w = cvt_pk_bf16(b[2], b[3]); return w; }

struct EpiQKV {
    static constexpr bool PERM = true, AFTER_DRAIN = false;
    bf16_t* base; int dl;
    __device__ __forceinline__ void operator()(const f32x4 (&acc)[2][2][4][2], const Unit& u, int wr, int wc, int fr, int fq) const {
        const int which = u.pn >> 2, h0 = (u.pn & 3) * 2, dcol = wc * 32 + 8 * fq;
        bf16_t* ob = base + (size_t)which * (size_t)(4 * 8 * 4096 * 128);
        const int row0 = u.pm * BM + wr * 64 + fr;
#pragma unroll
        for (int ai = 0; ai < 2; ++ai)
#pragma unroll
            for (int m = 0; m < 4; ++m) { const int row = row0 + ai * HALF + m * 16, b = row >> 12, t = row & 4095;
                const int sp = ((t & ((1 << dl) - 1)) << (12 - dl)) + (t >> dl);
#pragma unroll
                for (int bj = 0; bj < 2; ++bj) { bf16_t* p = ob + ((size_t)((b * 8 + h0 + bj) * 4096 + sp)) * 128 + dcol;
                    *(u32x4*)p = pack8(acc[ai][bj][m][0], acc[ai][bj][m][1]); } }
    }
};
struct EpiRes {
    static constexpr bool PERM = false, AFTER_DRAIN = false;
    const float* base; float* out; const float* gate;
    __device__ __forceinline__ void operator()(const f32x4 (&acc)[2][2][4][2], const Unit& u, int wr, int wc, int fr, int fq) const {
        const int row0 = u.pm * BM + wr * 64 + fr, col0 = u.pn * BM + wc * 32 + 4 * fq, b = (u.pm * BM) >> 12;
        f32x4 gv[2][2];
#pragma unroll
        for (int bj = 0; bj < 2; ++bj)
#pragma unroll
            for (int n = 0; n < 2; ++n) gv[bj][n] = *(const f32x4*)(gate + b * 6144 + col0 + bj * HALF + n * 16);
#pragma unroll
        for (int ai = 0; ai < 2; ++ai)
#pragma unroll
            for (int m = 0; m < 4; ++m) { const size_t off = (size_t)(row0 + ai * HALF + m * 16) * 1024 + col0;
#pragma unroll
                for (int bj = 0; bj < 2; ++bj)
#pragma unroll
                    for (int n = 0; n < 2; ++n) { const f32x4 bs = *(const f32x4*)(base + off + bj * HALF + n * 16);
                        *(f32x4*)(out + off + bj * HALF + n * 16) = bs + gv[bj][n] * acc[ai][bj][m][n]; } }
    }
};
struct EpiSwiGLU {
    static constexpr bool PERM = true, AFTER_DRAIN = false;
    bf16_t* H; int ldh;
    __device__ __forceinline__ void operator()(const f32x4 (&acc)[2][2][4][2], const Unit& u, int wr, int wc, int fr, int fq) const {
        const int row0 = u.pm * BM + wr * 64 + fr, col0 = u.pn * HALF + wc * 32 + 8 * fq;
#pragma unroll
        for (int ai = 0; ai < 2; ++ai)
#pragma unroll
            for (int m = 0; m < 4; ++m) { f32x4 r0, r1;
#pragma unroll
                for (int i = 0; i < 4; ++i) { r0[i] = silu_f(acc[ai][0][m][0][i]) * acc[ai][1][m][0][i]; r1[i] = silu_f(acc[ai][0][m][1][i]) * acc[ai][1][m][1][i]; }
                *(u32x4*)(H + (size_t)(row0 + ai * HALF + m * 16) * ldh + col0) = pack8(r0, r1); }
    }
};
struct EpiHgrnNaive {
    static constexpr bool PERM = true, AFTER_DRAIN = false;
    bf16_t* QS; float* FG; bf16_t* V; bf16_t* SG; const float* lbs;
    __device__ __forceinline__ void operator()(const f32x4 (&acc)[2][2][4][2], const Unit& u, int wr, int wc, int fr, int fq) const {
        typedef unsigned u32x2 __attribute__((ext_vector_type(2)));
        const int head = u.pn >> 1, type = u.pn & 1, col0 = head * 128 + wc * 32 + 8 * fq, row0 = u.pm * BM + wr * 64 + fr;
#pragma unroll
        for (int n = 0; n < 2; ++n) {
            const f32x4 lb = *(const f32x4*)(lbs + col0 + 4 * n);
#pragma unroll
            for (int ai = 0; ai < 2; ++ai)
#pragma unroll
                for (int m = 0; m < 4; ++m) { const size_t off = (size_t)(row0 + ai * HALF + m * 16) * 1024 + col0 + 4 * n; f32x4 a, b;
                    if (type == 0) {
#pragma unroll
                        for (int i = 0; i < 4; ++i) { a[i] = silu_f(acc[ai][0][m][n][i]); b[i] = lb[i] + (1.0f - lb[i]) * sigmoid_f(acc[ai][1][m][n][i]); }
                        u32x2 w; w.x = cvt_pk_bf16(a[0], a[1]); w.y = cvt_pk_bf16(a[2], a[3]); *(u32x2*)(QS + off) = w; *(f32x4*)(FG + off) = b;
                    } else {
#pragma unroll
                        for (int i = 0; i < 4; ++i) { a[i] = acc[ai][0][m][n][i]; b[i] = silu_f(acc[ai][1][m][n][i]); }
                        u32x2 w; w.x = cvt_pk_bf16(a[0], a[1]); w.y = cvt_pk_bf16(a[2], a[3]); *(u32x2*)(V + off) = w;
                        u32x2 x; x.x = cvt_pk_bf16(b[0], b[1]); x.y = cvt_pk_bf16(b[2], b[3]); *(u32x2*)(SG + off) = x;
                    }
                    asm volatile("" ::: "memory"); }
        }
    }
};

#define PG8_DPP(v, ctrl, bc) __builtin_bit_cast(float, __builtin_amdgcn_update_dpp(0, __builtin_bit_cast(int, (v)), (ctrl), 0xF, 0xF, (bc)))
struct EpiHgrn {
    static constexpr bool PERM = true, AFTER_DRAIN = false;
    bf16_t* QB; bf16_t* KD; bf16_t* KE; float* DEC; bf16_t* V; bf16_t* SG; const float* lbs;
    __device__ __forceinline__ void operator()(const f32x4 (&acc)[2][2][4][2], const Unit& u, int wr, int wc, int fr, int fq) const {
        typedef unsigned u32x2 __attribute__((ext_vector_type(2)));
        const int head = u.pn >> 1, type = u.pn & 1, col0 = head * 128 + wc * 32 + 8 * fq, row0 = u.pm * BM + wr * 64 + fr;
#pragma unroll
        for (int n = 0; n < 2; ++n) {
            const f32x4 lb = *(const f32x4*)(lbs + col0 + 4 * n);
#pragma unroll
            for (int ai = 0; ai < 2; ++ai)
#pragma unroll
                for (int m = 0; m < 4; ++m) { const int row = row0 + ai * HALF + m * 16; const size_t off = (size_t)row * 1024 + col0 + 4 * n;
                    if (type == 0) { f32x4 qb, kd, ke, dc;
#pragma unroll
                        for (int i = 0; i < 4; ++i) { const float q = acc[ai][0][m][n][i], f = acc[ai][1][m][n][i];
                            const float ea = __expf(-fabsf(f)), shi = __builtin_amdgcn_rcpf(1.0f + ea), slo = ea * shi, oml = 1.0f - lb[i];
                            const float sg = f >= 0.f ? shi : slo, fg = lb[i] + oml * sg, kin = oml * (f >= 0.f ? slo : shi), lf = __logf(fg);
                            float G = lf;
                            G += PG8_DPP(G, 0x111, true); G += PG8_DPP(G, 0x112, true); G += PG8_DPP(G, 0x114, true); G += PG8_DPP(G, 0x118, true);
                            float T = lf;
                            T += PG8_DPP(T, 0xB1, false); T += PG8_DPP(T, 0x4E, false); T += PG8_DPP(T, 0x141, false); T += PG8_DPP(T, 0x140, false);
                            qb[i] = silu_f(q) * __expf(G); ke[i] = kin * __expf(T - G); kd[i] = kin * __expf(fminf(-G, 80.0f)); dc[i] = __expf(T); }
                        u32x2 w; w.x = cvt_pk_bf16(qb[0], qb[1]); w.y = cvt_pk_bf16(qb[2], qb[3]); *(u32x2*)(QB + off) = w;
                        w.x = cvt_pk_bf16(kd[0], kd[1]); w.y = cvt_pk_bf16(kd[2], kd[3]); *(u32x2*)(KD + off) = w;
                        w.x = cvt_pk_bf16(ke[0], ke[1]); w.y = cvt_pk_bf16(ke[2], ke[3]); *(u32x2*)(KE + off) = w;
                        if (fr == 0) *(f32x4*)(DEC + (size_t)(row >> 4) * 1024 + col0 + 4 * n) = dc;
                    } else { f32x4 a, b;
#pragma unroll
                        for (int i = 0; i < 4; ++i) { a[i] = acc[ai][0][m][n][i]; b[i] = silu_f(acc[ai][1][m][n][i]); }
                        u32x2 w; w.x = cvt_pk_bf16(a[0], a[1]); w.y = cvt_pk_bf16(a[2], a[3]); *(u32x2*)(V + off) = w;
                        u32x2 x; x.x = cvt_pk_bf16(b[0], b[1]); x.y = cvt_pk_bf16(b[2], b[3]); *(u32x2*)(SG + off) = x;
                    }
                    asm volatile("" ::: "memory"); }
        }
    }
};

template <class Epi, class Sched, bool ALIGN_EPI = false, bool SP2 = false>
__device__ __forceinline__ void gemm_phase(PG8_LAS unsigned char* lds, const Gemm g, const Sched& S, const Epi& E, const int wave_) {
    const int tid_ = fresh_tid(__builtin_amdgcn_readfirstlane(wave_));
    const int tid = tid_, wid = __builtin_amdgcn_readfirstlane(tid >> 6), lane = tid & 63, wr = wid >> 2, wc = wid & 3, fr = lane & 15, fq = lane >> 4;
    const int K = g.K, nt = K / BK;
    unsigned voffA[2], voffB[2];
#pragma unroll
    for (int i = 0; i < 2; ++i) { int R, C; stage_rc(tid * 16 + i * 8192, R, C); const int Rb = Epi::PERM ? ((R & ~31) + perm32(R & 31)) : R;
        voffA[i] = (unsigned)(R * K + C) * 2u; voffB[i] = (unsigned)(Rb * K + C) * 2u; }
    const size_t kstep = (size_t)(BK * 2);
    const size_t hstep = (size_t)HALF * K * 2;
    const size_t tstep = 2 * hstep;
    const unsigned ldsw = (unsigned)wid * 1024u;
    const int aoff = lds_byte(wr * 64 + fr, fq * 8), boff = lds_byte(wc * 32 + fr, fq * 8);
#define PG8_SA(b, h) (((b) * 2 + (h)) * HTB)
#define PG8_SB(b, h) ((4 + (b) * 2 + (h)) * HTB)
#define PG8_STAGE(bufoff, gbase, voff) do { _Pragma("unroll") for (int _i = 0; _i < 2; ++_i) \
        __builtin_amdgcn_global_load_lds((const unsigned*)((const char*)(gbase) + (voff)[_i]), (PG8_LAS unsigned*)(lds + (bufoff) + ldsw + _i * 8192), 16, 0, 0); } while (0)
#define PG8_LDA(dst, b, h) do { _Pragma("unroll") for (int m = 0; m < 4; ++m) _Pragma("unroll") for (int k = 0; k < 2; ++k) dst[m][k] = *(const PG8_LAS bf16x8*)(lds + PG8_SA(b, h) + aoff + m * 2048 + k * 1024); } while (0)
#define PG8_LDB(dst, b, h) do { _Pragma("unroll") for (int n = 0; n < 2; ++n) _Pragma("unroll") for (int k = 0; k < 2; ++k) dst[n][k] = *(const PG8_LAS bf16x8*)(lds + PG8_SB(b, h) + boff + n * 2048 + k * 1024); } while (0)
#define PG8_MMA(ai, bj, At, Bt) do { __builtin_amdgcn_s_setprio(1); _Pragma("unroll") for (int m = 0; m < 4; ++m) _Pragma("unroll") for (int n = 0; n < 2; ++n) _Pragma("unroll") for (int k = 0; k < 2; ++k) \
        acc[ai][bj][m][n] = __builtin_amdgcn_mfma_f32_16x16x32_bf16(Bt[n][k], At[m][k], acc[ai][bj][m][n], 0, 0, 0); __builtin_amdgcn_s_setprio(0); } while (0)
#define PG8_WAIT_V(n) asm volatile("s_waitcnt vmcnt(" #n ")" ::: "memory")
#define PG8_WAIT_L(n) asm volatile("s_waitcnt lgkmcnt(" #n ")" ::: "memory")
#define PG8_BAR __builtin_amdgcn_s_barrier()
#define PG8_SCHED __builtin_amdgcn_sched_barrier(0)
    Unit cur, nxt; int ui = 0;
    if (!S.next(0, cur)) return;
    f32x4 acc[2][2][4][2];
#pragma unroll
    for (int a = 0; a < 2; ++a)
#pragma unroll
        for (int b = 0; b < 2; ++b)
#pragma unroll
            for (int m = 0; m < 4; ++m)
#pragma unroll
                for (int n = 0; n < 2; ++n) acc[a][b][m][n] = (f32x4){0.f, 0.f, 0.f, 0.f};
    bf16x8 At[4][2], B0[2][2], B1[2][2];
    const char* cA = (const char*)g.A + (size_t)cur.pm * tstep; const char* cB = (const char*)g.Bt + (size_t)cur.pn * tstep;
    S.a_ready(cur);
    if constexpr (SP2) {
        PG8_STAGE(PG8_SB(0, 0), cB, voffB); PG8_STAGE(PG8_SB(0, 1), cB + hstep, voffB); PG8_STAGE(PG8_SA(0, 0), cA, voffA); PG8_STAGE(PG8_SA(0, 1), cA + hstep, voffA);
        if (wr == 1) PG8_BAR;
        PG8_WAIT_V(2); PG8_BAR;
        PG8_STAGE(PG8_SB(1, 0), cB + kstep, voffB); PG8_STAGE(PG8_SA(1, 0), cA + kstep, voffA); PG8_STAGE(PG8_SB(1, 1), cB + hstep + kstep, voffB);
        PG8_WAIT_V(6); PG8_BAR;
    } else {
        PG8_STAGE(PG8_SB(0, 0), cB, voffB); PG8_STAGE(PG8_SA(0, 0), cA, voffA); PG8_STAGE(PG8_SB(0, 1), cB + hstep, voffB); PG8_STAGE(PG8_SA(0, 1), cA + hstep, voffA);
        if (wr == 1) PG8_BAR;
        PG8_WAIT_V(4); PG8_BAR;
        PG8_STAGE(PG8_SB(1, 0), cB + kstep, voffB); PG8_STAGE(PG8_SA(1, 0), cA + kstep, voffA); PG8_STAGE(PG8_SB(1, 1), cB + hstep + kstep, voffB);
        PG8_WAIT_V(6); PG8_BAR;
    }
    for (;;) {
        const bool has_next = S.next(ui + 1, nxt);
        const char* nA = has_next ? (const char*)g.A + (size_t)nxt.pm * tstep : cA; const char* nB = has_next ? (const char*)g.Bt + (size_t)nxt.pn * tstep : cB;
        for (int t = 0; t < nt; t += 2) {
            const bool last = (t == nt - 2);
            const char* a1 = cA + (size_t)(t + 1) * kstep;
            const char* a2 = last ? nA : cA + (size_t)(t + 2) * kstep; const char* b2 = last ? nB : cB + (size_t)(t + 2) * kstep;
            const char* a3 = a2 + kstep; const char* b3 = b2 + kstep;
            if (last && has_next) S.a_ready(nxt);
            if constexpr (SP2) {
            PG8_LDB(B0, 0, 0); PG8_LDB(B1, 0, 1); PG8_SCHED; PG8_LDA(At, 0, 0); PG8_STAGE(PG8_SA(1, 1), a1 + hstep, voffA);
            PG8_WAIT_V(8); PG8_WAIT_L(0); PG8_BAR; PG8_MMA(0, 0, At, B0); PG8_MMA(0, 1, At, B1); PG8_BAR; PG8_SCHED;
            PG8_LDA(At, 0, 1); PG8_STAGE(PG8_SB(0, 0), b2, voffB); PG8_STAGE(PG8_SB(0, 1), b2 + hstep, voffB); PG8_STAGE(PG8_SA(0, 0), a2, voffA);
            PG8_WAIT_V(8); PG8_WAIT_L(0); PG8_BAR; PG8_MMA(1, 0, At, B0); PG8_MMA(1, 1, At, B1); PG8_BAR; PG8_SCHED;
            PG8_LDB(B0, 1, 0); PG8_LDB(B1, 1, 1); PG8_SCHED; PG8_LDA(At, 1, 0); PG8_STAGE(PG8_SA(0, 1), a2 + hstep, voffA);
            PG8_WAIT_V(8); PG8_WAIT_L(0); PG8_BAR; PG8_MMA(0, 0, At, B0); PG8_MMA(0, 1, At, B1); PG8_BAR; PG8_SCHED;
            PG8_LDA(At, 1, 1); PG8_STAGE(PG8_SB(1, 0), b3, voffB); PG8_STAGE(PG8_SB(1, 1), b3 + hstep, voffB); PG8_STAGE(PG8_SA(1, 0), a3, voffA);
            PG8_WAIT_V(8); PG8_WAIT_L(0); PG8_BAR; PG8_MMA(1, 0, At, B0); PG8_MMA(1, 1, At, B1); PG8_BAR; PG8_SCHED;
            } else {
            PG8_LDB(B0, 0, 0); PG8_SCHED; PG8_LDA(At, 0, 0); PG8_STAGE(PG8_SA(1, 1), a1 + hstep, voffA);
            PG8_WAIT_L(8); PG8_BAR; PG8_WAIT_L(0); PG8_MMA(0, 0, At, B0); PG8_BAR; PG8_SCHED;
            PG8_LDB(B1, 0, 1); PG8_STAGE(PG8_SB(0, 0), b2, voffB);
            PG8_BAR; PG8_WAIT_L(0); PG8_MMA(0, 1, At, B1); PG8_BAR;
            PG8_LDA(At, 0, 1); PG8_STAGE(PG8_SA(0, 0), a2, voffA);
            PG8_BAR; PG8_WAIT_L(0); PG8_MMA(1, 0, At, B0); PG8_BAR; PG8_SCHED;
            PG8_STAGE(PG8_SB(0, 1), b2 + hstep, voffB);
            PG8_WAIT_V(6); PG8_BAR; PG8_MMA(1, 1, At, B1); PG8_BAR;
            PG8_LDB(B0, 1, 0); PG8_SCHED; PG8_LDA(At, 1, 0); PG8_STAGE(PG8_SA(0, 1), a2 + hstep, voffA);
            PG8_WAIT_L(8); PG8_BAR; PG8_WAIT_L(0); PG8_MMA(0, 0, At, B0); PG8_BAR; PG8_SCHED;
            PG8_LDB(B1, 1, 1); PG8_STAGE(PG8_SB(1, 0), b3, voffB);
            PG8_BAR; PG8_WAIT_L(0); PG8_MMA(0, 1, At, B1); PG8_BAR;
            PG8_LDA(At, 1, 1); PG8_STAGE(PG8_SA(1, 0), a3, voffA);
            PG8_BAR; PG8_WAIT_L(0); PG8_MMA(1, 0, At, B0); PG8_BAR; PG8_SCHED;
            PG8_STAGE(PG8_SB(1, 1), b3 + hstep, voffB);
            PG8_WAIT_V(6); PG8_BAR; PG8_MMA(1, 1, At, B1); PG8_BAR;
            }
        }
        if constexpr (ALIGN_EPI) { if (wr == 0) PG8_BAR; }
        if constexpr (!Epi::AFTER_DRAIN) { E(acc, cur, wr, wc, fr, fq); S.done(cur); }
        if (!has_next) break;
#pragma unroll
        for (int a = 0; a < 2; ++a)
#pragma unroll
            for (int b = 0; b < 2; ++b)
#pragma unroll
                for (int m = 0; m < 4; ++m)
#pragma unroll
                    for (int n = 0; n < 2; ++n) acc[a][b][m][n] = (f32x4){0.f, 0.f, 0.f, 0.f};
        cur = nxt; cA = nA; cB = nB; ++ui;
        if constexpr (ALIGN_EPI) { if (wr == 1) PG8_BAR; }
    }
    PG8_WAIT_V(0);
    if constexpr (!ALIGN_EPI) { if (wr == 0) PG8_BAR; }
    PG8_BAR;
    if constexpr (Epi::AFTER_DRAIN) { E.fused(acc, cur, wr, wc, fr, fq, lds, wid, lane); S.done(cur); }
#undef PG8_SA
#undef PG8_SB
#undef PG8_STAGE
#undef PG8_LDA
#undef PG8_LDB
#undef PG8_MMA
#undef PG8_WAIT_V
#undef PG8_WAIT_L
#undef PG8_BAR
#undef PG8_SCHED
}
}
#define GAS __attribute__((address_space(1)))
#define LAS __attribute__((address_space(3)))
typedef unsigned short bf16;
typedef unsigned v4u __attribute__((ext_vector_type(4)));
typedef float f32x4 __attribute__((ext_vector_type(4)));
typedef short bf16x8 __attribute__((ext_vector_type(8)));
typedef GAS unsigned gu32;
typedef GAS unsigned long long gu64;
#define RLX_AGENT __ATOMIC_RELAXED, __HIP_MEMORY_SCOPE_AGENT
#define LDS_WAIT() asm volatile("s_waitcnt lgkmcnt(0)" ::: "memory")
#define VM_WAIT() asm volatile("s_waitcnt vmcnt(0)" ::: "memory")
__device__ __forceinline__ unsigned long long rt() { return __builtin_amdgcn_s_memrealtime(); }
__device__ __forceinline__ unsigned f2bf(float f) { unsigned u = __builtin_bit_cast(unsigned, f); return (u + 0x7fffu + ((u >> 16) & 1u)) >> 16; }
__device__ __forceinline__ unsigned pk2(float lo, float hi) { return f2bf(lo) | (f2bf(hi) << 16); }

#define XB_TMO      128
#define XB_XCNT(j)  (256  + 64 * (j))
#define XB_XSUB(j)  (1280 + 64 * (j))
#define XB_XGEN(j)  (2304 + 64 * (j))
#define XB_TOP      3328
#define XB_TOPGEN   3392
#define XCD_BAR_WORDS 3456
#define XB_SPIN_CAP (1u << 18)

__device__ __forceinline__ unsigned xb_ld(unsigned* p)              { return __hip_atomic_load(p, __ATOMIC_RELAXED, __HIP_MEMORY_SCOPE_AGENT); }
__device__ __forceinline__ unsigned xb_add(unsigned* p, unsigned v) { return __hip_atomic_fetch_add(p, v, __ATOMIC_RELAXED, __HIP_MEMORY_SCOPE_AGENT); }
__device__ __forceinline__ unsigned xb_xcc_id() { return (unsigned)__builtin_amdgcn_s_getreg((3 << 11) | 20) & 0xFu; }
#define XB_SPIN(cond, bar) do { unsigned _sp = 0; while (cond) { __builtin_amdgcn_s_sleep(1); \
    if ((++_sp & 255u) == 0u) { if (xb_ld(&(bar)[XB_TMO])) break; if (_sp > XB_SPIN_CAP) { atomicAdd(&(bar)[XB_TMO], 1u); break; } } } } while (0)


struct XcdBarrier {
    unsigned* bar; unsigned x; int wave;
    volatile LAS unsigned* st;
};

__device__ __forceinline__ XcdBarrier xcd_barrier_post(unsigned* bar, volatile LAS unsigned* st, int wave) {
    XcdBarrier b; b.bar = bar; b.x = xb_xcc_id(); b.st = st; b.wave = wave;
    if (fresh_tid(wave) == 0) (void)xb_add(&bar[XB_XCNT(b.x)], 1u);
    return b;
}
__device__ __forceinline__ void xcd_barrier_complete(unsigned* bar, unsigned x, unsigned& nloc, unsigned& nx) {
    const unsigned G = gridDim.x * gridDim.y * gridDim.z;
    unsigned sum, cnt, mine, sp = 0u;
    for (;;) {
        sum = 0u; cnt = 0u; mine = 0u;
#pragma unroll
        for (unsigned j = 0; j < 16; ++j) { const unsigned c = xb_ld(&bar[XB_XCNT(j)]); sum += c; cnt += (c > 0u) ? 1u : 0u; mine = (j == x) ? c : mine; }
        if (sum == G) break;
        __builtin_amdgcn_s_sleep(1);
        if ((++sp & 255u) == 0u) { if (xb_ld(&bar[XB_TMO])) break; if (sp > XB_SPIN_CAP) { atomicAdd(&bar[XB_TMO], 1u); break; } }
    }
    nloc = mine > 0u ? mine : 1u; nx = cnt > 0u ? cnt : 1u;
}

__device__ __forceinline__ void xcd_barrier(const XcdBarrier& b) {
    asm volatile("s_waitcnt vmcnt(0)" ::: "memory");
    __syncthreads();
    if (fresh_tid(b.wave) == 0) {
        unsigned* bar = b.bar;
        __builtin_amdgcn_s_waitcnt(0);
        unsigned nloc = b.st[0], nx = b.st[1];
        if (nloc == 0u) { xcd_barrier_complete(bar, b.x, nloc, nx); b.st[0] = nloc; b.st[1] = nx; }
        const unsigned old = xb_add(&bar[XB_XSUB(b.x)], 1u);
        const unsigned gen = old / nloc;
        if (old + 1u == (gen + 1u) * nloc) {
            __builtin_amdgcn_fence(__ATOMIC_RELEASE, "agent");
            asm volatile("s_waitcnt vmcnt(0)" ::: "memory");
            const unsigned og = xb_add(&bar[XB_TOP], 1u);
            const unsigned tg = og / nx;
            if (og + 1u == (tg + 1u) * nx) xb_add(&bar[XB_TOPGEN], 1u);
            else XB_SPIN(xb_ld(&bar[XB_TOPGEN]) == tg, bar);
            __builtin_amdgcn_fence(__ATOMIC_ACQUIRE, "agent");
            xb_add(&bar[XB_XGEN(b.x)], 1u);
            asm volatile("s_waitcnt vmcnt(0)" ::: "memory");
        } else {
            XB_SPIN(xb_ld(&bar[XB_XGEN(b.x)]) == gen, bar);
            __builtin_amdgcn_fence(__ATOMIC_ACQUIRE, "agent");
            asm volatile("s_waitcnt vmcnt(0)" ::: "memory");
        }
    }
    __syncthreads();
}

namespace att {
#define ATT_LAS __attribute__((address_space(3)))
typedef unsigned short bf16_t;
typedef short bf16x8 __attribute__((ext_vector_type(8)));
typedef short s16x4 __attribute__((ext_vector_type(4)));
typedef float f32x16 __attribute__((ext_vector_type(16)));
typedef float f32x4 __attribute__((ext_vector_type(4)));
typedef unsigned u32x4 __attribute__((ext_vector_type(4)));
typedef ATT_LAS char* lptr;
constexpr int D = 128, NW = 8, QBLK = 32, KVBLK = 64, QB = NW * QBLK, W = 129;
constexpr int SHM_V = KVBLK * D * 2, SHM_K = KVBLK * D * 2;
constexpr int LDS_WSC = 2 * SHM_V + 2 * SHM_K;
constexpr int LUTW = 320, LUT_OFF = 96;
constexpr int LDS_LUT = LDS_WSC + NW * 64 * 4;
constexpr int LDS_BYTES = LDS_LUT + 8 * LUTW * 4;
constexpr float SCALE = 0.08838834764831845f, THR = 0.f, EPS = 1e-6f;
constexpr bool SK = true;

#define KSWZ(row, colB) ((row) * 256 + ((colB) ^ (((row) & 7) << 4)))
#define SBAR() __builtin_amdgcn_sched_barrier(0)
__device__ __forceinline__ int v_st(int k, int c) { const int kk = (k & ~0xC) | ((k & 4) << 1) | ((k & 8) >> 1); return ((kk >> 3) * 4 + (c >> 5)) * 512 + ((kk & 7) * 32 + (c & 31)) * 2; }
__device__ __forceinline__ int v_rd_base(int lane) { return ((lane & 3) << 3) | (((lane >> 2) & 3) << 6) | (((lane >> 4) & 1) << 5) | (((lane >> 5) & 1) << 8); }
constexpr int v_rd_off(int d0, int ks, int half) { return d0 * 512 + ks * 4096 + half * 2048; }
__device__ __forceinline__ int crow(int r, int hi) { return (r & 3) + 8 * (r >> 2) + 4 * hi; }
__device__ __forceinline__ unsigned cvtpk(float lo, float hi) { unsigned r; asm volatile("v_cvt_pk_bf16_f32 %0, %1, %2" : "=v"(r) : "v"(lo), "v"(hi)); return r; }
__device__ __forceinline__ float bfe(bf16x8 v, int j) { return __builtin_bit_cast(float, (unsigned)(unsigned short)v[j] << 16); }
__device__ __forceinline__ float dpp_sum16(float v) {
    v += __builtin_bit_cast(float, __builtin_amdgcn_update_dpp(0, __builtin_bit_cast(int, v), 0xB1, 0xF, 0xF, false));
    v += __builtin_bit_cast(float, __builtin_amdgcn_update_dpp(0, __builtin_bit_cast(int, v), 0x4E, 0xF, 0xF, false));
    v += __builtin_bit_cast(float, __builtin_amdgcn_update_dpp(0, __builtin_bit_cast(int, v), 0x141, 0xF, 0xF, false));
    v += __builtin_bit_cast(float, __builtin_amdgcn_update_dpp(0, __builtin_bit_cast(int, v), 0x140, 0xF, 0xF, false));
    return v;
}
__device__ __forceinline__ bf16x8 knorm(bf16x8 k) {
    float f[8]; float ss = 0.f;
#pragma unroll
    for (int j = 0; j < 8; ++j) { f[j] = bfe(k, j); ss += f[j] * f[j]; }
    const float rs = __builtin_amdgcn_rsqf(dpp_sum16(ss) * (1.0f / D) + EPS);
    u32x4 w = {cvtpk(f[0] * rs, f[1] * rs), cvtpk(f[2] * rs, f[3] * rs), cvtpk(f[4] * rs, f[5] * rs), cvtpk(f[6] * rs, f[7] * rs)};
    return __builtin_bit_cast(bf16x8, w);
}
__device__ __forceinline__ void q_normalize(bf16x8* qr, const float* gq, int hi) {
    float ss = 0.f;
#pragma unroll
    for (int d0 = 0; d0 < 8; ++d0)
#pragma unroll
        for (int j = 0; j < 8; ++j) { const float f = bfe(qr[d0], j); ss += f * f; }
    { auto rr = __builtin_amdgcn_permlane32_swap(__float_as_uint(ss), __float_as_uint(ss), false, false); ss = __uint_as_float(rr[0]) + __uint_as_float(rr[1]); }
    const float rs = __builtin_amdgcn_rsqf(ss * (1.0f / D) + EPS);
#pragma unroll
    for (int d0 = 0; d0 < 8; ++d0) { const f32x4 g0 = *(const f32x4*)((const char*)gq + (unsigned)(hi * 32) + d0 * 64), g1 = *(const f32x4*)((const char*)gq + (unsigned)(hi * 32) + d0 * 64 + 16);
        u32x4 w = {cvtpk(bfe(qr[d0], 0) * rs * g0[0], bfe(qr[d0], 1) * rs * g0[1]), cvtpk(bfe(qr[d0], 2) * rs * g0[2], bfe(qr[d0], 3) * rs * g0[3]),
                   cvtpk(bfe(qr[d0], 4) * rs * g1[0], bfe(qr[d0], 5) * rs * g1[1]), cvtpk(bfe(qr[d0], 6) * rs * g1[2], bfe(qr[d0], 7) * rs * g1[3])};
        qr[d0] = __builtin_bit_cast(bf16x8, w); }
}
__device__ __forceinline__ void mask_tile(f32x16& p0, f32x16& p1, int dq, unsigned Wn) {
    const float NEG = -__builtin_inff();
#pragma unroll
    for (int r = 0; r < 16; ++r) { const int c = (r & 3) + 8 * (r >> 2);
        if ((unsigned)(dq - c) >= Wn) p0[r] = NEG;
        if ((unsigned)(dq - c - 32) >= Wn) p1[r] = NEG; }
}
__device__ __forceinline__ void bias_tile(f32x16& p0, f32x16& p1, const ATT_LAS float* lb) {
#pragma unroll
    for (int r = 0; r < 16; ++r) { const int c = (r & 3) + 8 * (r >> 2); p0[r] += lb[63 - c]; p1[r] += lb[31 - c]; }
}
__device__ __forceinline__ void partialSM(f32x16& p0, f32x16& p1, float& m_reg, float& mn, float& alpha) {
    float pmax = p0[0];
#pragma unroll
    for (int r = 1; r < 16; ++r) pmax = fmaxf(pmax, p0[r]);
#pragma unroll
    for (int r = 0; r < 16; ++r) pmax = fmaxf(pmax, p1[r]);
    { auto rr = __builtin_amdgcn_permlane32_swap(__float_as_uint(pmax), __float_as_uint(pmax), false, false);
      pmax = fmaxf(__uint_as_float(rr[0]), __uint_as_float(rr[1])); }
    constexpr float C2 = 1.4426950408889634f * SCALE;
    if (__builtin_expect(__all((pmax - m_reg) * SCALE <= THR), 1)) { mn = m_reg; alpha = 1.f; }
    else { mn = fmaxf(m_reg, pmax); alpha = __builtin_amdgcn_exp2f((m_reg - mn) * C2); m_reg = mn; }
    const float mnL = -mn * C2;
#pragma unroll
    for (int r = 0; r < 16; ++r) p0[r] = fmaf(p0[r], C2, mnL);
#pragma unroll
    for (int r = 0; r < 16; ++r) p1[r] = fmaf(p1[r], C2, mnL);
#pragma unroll
    for (int r = 0; r < 16; ++r) p0[r] = __builtin_amdgcn_exp2f(p0[r]);
}
__device__ __forceinline__ void finishSM(f32x16& p0, f32x16& p1, float alpha, float& l_reg, bf16x8& pa0, bf16x8& pa1, bf16x8& pa2, bf16x8& pa3) {
#pragma unroll
    for (int r = 0; r < 16; ++r) p1[r] = __builtin_amdgcn_exp2f(p1[r]);
    float ps = 0;
#pragma unroll
    for (int r = 0; r < 16; ++r) ps += p0[r];
#pragma unroll
    for (int r = 0; r < 16; ++r) ps += p1[r];
    { auto rr = __builtin_amdgcn_permlane32_swap(__float_as_uint(ps), __float_as_uint(ps), false, false);
      ps = __uint_as_float(rr[0]) + __uint_as_float(rr[1]); }
    l_reg = l_reg * alpha + ps;
#define PK4(P, B_, OUT) do { unsigned a0 = cvtpk(P[B_+0], P[B_+1]), a1 = cvtpk(P[B_+2], P[B_+3]);                          \
        unsigned b0 = cvtpk(P[B_+4], P[B_+5]), b1 = cvtpk(P[B_+6], P[B_+7]);                                             \
        auto r0 = __builtin_amdgcn_permlane32_swap(a0, b0, false, false); auto r1 = __builtin_amdgcn_permlane32_swap(a1, b1, false, false); \
        u32x4 w = {r0[0], r1[0], r0[1], r1[1]}; OUT = __builtin_bit_cast(bf16x8, w); } while (0)
    PK4(p0, 0, pa0); PK4(p0, 8, pa1); PK4(p1, 0, pa2); PK4(p1, 8, pa3);
#undef PK4
}
template <int KB>
__device__ __forceinline__ void qkt(f32x16& p0, f32x16& p1, lptr K_lds, int r32, int hi, const bf16x8* qr, bool act) {
    if (SK && !act) { const float NEG = -__builtin_inff();
#pragma unroll
        for (int r = 0; r < 16; ++r) { p0[r] = NEG; p1[r] = NEG; } return; }
    p0 = f32x16{}; p1 = f32x16{};
    lptr kb[4];
#pragma unroll
    for (int dd = 0; dd < 4; ++dd) kb[dd] = K_lds + KB * SHM_K + KSWZ(r32, (dd * 16 + hi * 8) * 2);
#pragma unroll
    for (int d0 = 0; d0 < 8; ++d0) { lptr a = kb[d0 & 3] + (d0 >> 2) * 128;
        bf16x8 b0 = *(const ATT_LAS bf16x8*)(a);
        bf16x8 b1 = *(const ATT_LAS bf16x8*)(a + 32 * 256);
        p0 = __builtin_amdgcn_mfma_f32_32x32x16_bf16(b0, qr[d0], p0, 0, 0, 0);
        p1 = __builtin_amdgcn_mfma_f32_32x32x16_bf16(b1, qr[d0], p1, 0, 0, 0); }
}
template <int VB>
__device__ __forceinline__ void pv_tile(f32x16* o, int vb0, bf16x8 pa0, bf16x8 pa1, bf16x8 pa2, bf16x8 pa3, bool act) {
    if (SK && !act) return;
#define TRRD(dst, off) asm volatile("ds_read_b64_tr_b16 %0, %1 offset:%2" : "=&v"(dst) : "v"(vb0), "i"(off) : "memory")
#define PV_D0(d0) do { s16x4 l0, l1, l2, l3, h0, h1, h2, h3; constexpr int b_ = VB * SHM_V + v_rd_off(d0, 0, 0); \
        TRRD(l0, b_); TRRD(h0, b_ + 2048); TRRD(l1, b_ + 4096); TRRD(h1, b_ + 6144); TRRD(l2, b_ + 8192); TRRD(h2, b_ + 10240); TRRD(l3, b_ + 12288); TRRD(h3, b_ + 14336); \
        asm volatile("s_waitcnt lgkmcnt(0)" ::: "memory"); SBAR();   \
        o[d0] = __builtin_amdgcn_mfma_f32_32x32x16_bf16(pa0, (bf16x8){l0[0], l0[1], l0[2], l0[3], h0[0], h0[1], h0[2], h0[3]}, o[d0], 0, 0, 0);   \
        o[d0] = __builtin_amdgcn_mfma_f32_32x32x16_bf16(pa1, (bf16x8){l1[0], l1[1], l1[2], l1[3], h1[0], h1[1], h1[2], h1[3]}, o[d0], 0, 0, 0);   \
        o[d0] = __builtin_amdgcn_mfma_f32_32x32x16_bf16(pa2, (bf16x8){l2[0], l2[1], l2[2], l2[3], h2[0], h2[1], h2[2], h2[3]}, o[d0], 0, 0, 0);   \
        o[d0] = __builtin_amdgcn_mfma_f32_32x32x16_bf16(pa3, (bf16x8){l3[0], l3[1], l3[2], l3[3], h3[0], h3[1], h3[2], h3[3]}, o[d0], 0, 0, 0); } while (0)
    PV_D0(0); PV_D0(1); PV_D0(2); PV_D0(3);
#undef PV_D0
#undef TRRD
}

struct BlockRef { const bf16_t* Q; const bf16_t* K; const bf16_t* V; bf16_t* O; float* LSE; int P0, lut; };
struct Seam { bf16x8 qr[8]; bf16x8 st_v0, st_v1, st_k0, st_k1; };
struct PhaseConst { int skv, ostr, lstr; const float* gq; };
__device__ __forceinline__ int swa_jlo(int P0) { const int lowk = P0 - W + 1; return lowk > 0 ? lowk / KVBLK : 0; }
#define ROW(p, k0, rr) ((const char*)((p) + (size_t)((k0) + (rr)) * D) + kvoff)
#define VMW() asm volatile("s_waitcnt vmcnt(0)" ::: "memory")
#define VMWN(n) asm volatile("s_waitcnt vmcnt(%0)" :: "i"(n) : "memory")
#define LD8(p) (*reinterpret_cast<const bf16x8*>(p))
#define QROWP(Qp, wid) ((const char*)((Qp) + (size_t)((wid) * QBLK) * D) + qoff)
#define SLOAD_H(Kp, Vp, k0) do { S.st_v0 = LD8(ROW(Vp, k0, 0)); S.st_v1 = LD8(ROW(Vp, k0, 32)); S.st_k0 = LD8(ROW(Kp, k0, 0)); S.st_k1 = LD8(ROW(Kp, k0, 32)); } while (0)
#define SWRITE_HK(bf) do { *(ATT_LAS bf16x8*)(K_lds + (bf) * SHM_K + kws) = knorm(S.st_k0); *(ATT_LAS bf16x8*)(K_lds + (bf) * SHM_K + kws + 32 * 256) = knorm(S.st_k1); } while (0)
#define SWRITE_HV(bf) do { *(ATT_LAS bf16x8*)(V_lds + (bf) * SHM_V + vst0) = S.st_v0; *(ATT_LAS bf16x8*)(V_lds + (bf) * SHM_V + vst0 + 8192) = S.st_v1;     } while (0)
#define SWRITE_H(bf) do { SWRITE_HV(bf); SWRITE_HK(bf); } while (0)
__device__ __forceinline__ void swa_prime(const BlockRef& cur, lptr lds, Seam& S, const int tid) {
    const int wid = __builtin_amdgcn_readfirstlane(tid >> 6), lane = tid & 63, r32 = lane & 31, hi = lane >> 5;
    const int sr = tid >> 4, sc = (tid & 15) * 8, kws = KSWZ(sr, sc * 2); lptr K_lds = lds + 2 * SHM_V;
    const unsigned kvoff = (unsigned)(sr * D + sc) * 2u, qoff = (unsigned)(r32 * D + hi * 8) * 2u;
    const int kb0 = swa_jlo(cur.P0) * KVBLK;
#pragma unroll
    for (int d0 = 0; d0 < 8; ++d0) S.qr[d0] = LD8(QROWP(cur.Q, wid) + d0 * 32);
    SLOAD_H(cur.K, cur.V, kb0); VMW(); SWRITE_HK(0);
    __syncthreads();
}
__device__ __forceinline__ void swa_block(const BlockRef& cur, const BlockRef& nxt, const PhaseConst& pc, lptr lds, Seam& S, const int tid) {
    const int wid = __builtin_amdgcn_readfirstlane(tid >> 6), lane = tid & 63, r32 = lane & 31, hi = lane >> 5;
    const int j_lo = swa_jlo(cur.P0);
    int j_hi = (cur.P0 + QB - 1) / KVBLK + 1; if (j_hi > pc.skv / KVBLK) j_hi = pc.skv / KVBLK;
    const int NT = j_hi - j_lo;
    const int kbn = swa_jlo(nxt.P0) * KVBLK;
    const int qlo = cur.P0 + wid * QBLK, qm = qlo + r32 - 4 * hi;
    lptr V_lds = lds; lptr K_lds = lds + 2 * SHM_V;
    ATT_LAS float* wsc = (ATT_LAS float*)(lds + LDS_WSC) + wid * 64; ATT_LAS float* li_l = wsc; ATT_LAS float* al_l = wsc + 32;
    const ATT_LAS float* lutq = (const ATT_LAS float*)(lds + LDS_LUT + cur.lut) + (LUT_OFF - 63) + qm;
    float m_reg = -1e30f, l_reg = 0; f32x16 o[4] = {};
    const int sr = tid >> 4, sc = (tid & 15) * 8, vst0 = v_st(sr, sc), kws = KSWZ(sr, sc * 2);
    const unsigned kvoff = (unsigned)(sr * D + sc) * 2u, qoff = (unsigned)(r32 * D + hi * 8) * 2u;
    const int vb0 = (int)(unsigned)(uintptr_t)V_lds + v_rd_base(lane);
    const bf16_t* Kh = cur.K; const bf16_t* Vh = cur.V;
    q_normalize(S.qr, pc.gq, hi);
#define RESC(a) do { if (__any((a) < 1.f)) { if (hi == 0) al_l[r32] = (a); asm volatile("s_waitcnt lgkmcnt(0)" ::: "memory");              \
                     _Pragma("unroll") for (int d_ = 0; d_ < 4; ++d_) _Pragma("unroll") for (int r = 0; r < 16; ++r) o[d_][r] *= al_l[crow(r, hi)]; } } while (0)
#define KBASE(t) ((j_lo + (t)) * KVBLK)
#define ACT(t) (KBASE(t) <= qlo + QBLK - 1 && KBASE(t) + KVBLK - 1 >= qlo - W + 1)
#define MASKT(P0_, P1_, t) do { const int kb_ = KBASE(t); if (ACT(t)) { bias_tile(P0_, P1_, lutq - kb_); \
        if (kb_ + KVBLK - 1 > qlo || kb_ <= qlo + QBLK - 1 - W) mask_tile(P0_, P1_, qm - kb_, (unsigned)W); } } while (0)
    constexpr int NQL = 8;
#define SEAM_K0() do { VMWN(NQL); SWRITE_HK(0); SBAR(); } while (0)
    f32x16 pA0, pA1, pB0, pB1; float mnA, mnB, alA, alB; bf16x8 pa0, pa1, pa2, pa3;
    SWRITE_HV(0); SBAR();
    if (NT > 1) { SLOAD_H(Kh, Vh, KBASE(1)); }
    SBAR(); qkt<0>(pA0, pA1, K_lds, r32, hi, S.qr, ACT(0));
    MASKT(pA0, pA1, 0); partialSM(pA0, pA1, m_reg, mnA, alA);
    if (NT > 1) { VMW(); SWRITE_H(1); }
    __syncthreads();
#define HALF_STEP(PX0, PX1, mnX, alX, PY0, PY1, alY, t, KB, VB, SB) do {                                                      \
        SBAR(); qkt<KB>(PX0, PX1, K_lds, r32, hi, S.qr, ACT(t));                                             \
        finishSM(PY0, PY1, alY, l_reg, pa0, pa1, pa2, pa3); SBAR();                                                           \
        if ((t) + 1 < NT) { SLOAD_H(Kh, Vh, KBASE((t) + 1)); SBAR(); }                                               \
        pv_tile<VB>(o, vb0, pa0, pa1, pa2, pa3, ACT((t) - 1)); MASKT(PX0, PX1, (t)); partialSM(PX0, PX1, m_reg, mnX, alX);                                        \
        __syncthreads();                                                                                                      \
        if ((t) + 1 < NT) { VMW(); SWRITE_H(SB); }                                                                          \
        RESC(alX); __syncthreads(); } while (0)
    for (int t = 1; t + 1 < NT; t += 2) {
        HALF_STEP(pB0, pB1, mnB, alB, pA0, pA1, alA, t, 1, 0, 0);
        HALF_STEP(pA0, pA1, mnA, alA, pB0, pB1, alB, t + 1, 0, 1, 1);
    }
    const bool even = (NT & 1) == 0;
    if (even) { SBAR(); qkt<1>(pB0, pB1, K_lds, r32, hi, S.qr, ACT(NT - 1)); SBAR(); }
    SLOAD_H(nxt.K, nxt.V, kbn); SBAR();
#pragma unroll
    for (int d0 = 0; d0 < 8; ++d0) S.qr[d0] = LD8(QROWP(nxt.Q, wid) + d0 * 32);
    SBAR();
    finishSM(pA0, pA1, alA, l_reg, pa0, pa1, pa2, pa3); SBAR();
    pv_tile<0>(o, vb0, pa0, pa1, pa2, pa3, ACT(even ? NT - 2 : NT - 1));
    if (even) { MASKT(pB0, pB1, NT - 1); partialSM(pB0, pB1, m_reg, mnB, alB); __syncthreads(); RESC(alB);
        finishSM(pB0, pB1, alB, l_reg, pa0, pa1, pa2, pa3); SBAR(); pv_tile<1>(o, vb0, pa0, pa1, pa2, pa3, ACT(NT - 1)); }
    SBAR(); SEAM_K0();
    if (hi == 0) { li_l[r32] = l_reg; *(float*)((char*)(cur.LSE + (size_t)(wid * QBLK) * pc.lstr) + (unsigned)(r32 * pc.lstr) * 4u) = m_reg * (1.4426950408889634f * SCALE) + __builtin_amdgcn_logf(l_reg); }
    asm volatile("s_waitcnt lgkmcnt(0)" ::: "memory");
    float rli[16];
#pragma unroll
    for (int r = 0; r < 16; ++r) rli[r] = __builtin_amdgcn_rcpf(li_l[crow(r, hi)]);
    char* Ow = (char*)(cur.O + (size_t)(wid * QBLK) * pc.ostr) + (unsigned)(r32 * 2); const unsigned ostrb = (unsigned)pc.ostr * 2u;
#pragma unroll
    for (int r = 0; r < 16; ++r) { const int orow = crow(r, hi);
#pragma unroll
        for (int d0 = 0; d0 < 4; ++d0) { const float v = o[d0][r] * rli[r]; const float vn = __shfl_xor(v, 1);
            if ((r32 & 1) == 0) *(unsigned*)(Ow + (unsigned)orow * ostrb + d0 * 64) = cvtpk(v, vn); } }
    __syncthreads();
#undef RESC
#undef KBASE
#undef ACT
#undef MASKT
#undef SEAM_K0
#undef HALF_STEP
}
#undef ROW
#undef VMW
#undef VMWN
#undef SLOAD_H
#undef SWRITE_HK
#undef SWRITE_HV
#undef SWRITE_H
#undef LD8
#undef QROWP

struct Tensors { const bf16_t* Q; const bf16_t* K; const bf16_t* V; bf16_t* O; float* LSE; const float* lut; const float* gq; };
__device__ __forceinline__ BlockRef unit_ref(const Tensors& T, int u, int dl) {
    const int nqbl = 4 - dl, qb = u & ((1 << nqbl) - 1), t = u >> nqbl, r = t & ((1 << dl) - 1), bh = t >> dl, b = bh >> 3, h = bh & 7;
    const size_t base = ((size_t)bh * 4096 + ((size_t)r << (12 - dl))) * D;
    const size_t tok = (size_t)b * 4096 + ((size_t)(qb * QB) << dl) + r;
    BlockRef R; R.Q = T.Q + base + (size_t)qb * QB * D; R.K = T.K + base; R.V = T.V + base; R.O = T.O + tok * 1024 + h * D; R.LSE = T.LSE + tok * 8 + h; R.P0 = qb * QB; R.lut = h * LUTW * 4;
    return R;
}
__device__ __forceinline__ void attn_phase(lptr lds, const Tensors& T, int dl, int vcu, int G, int wave) {
    constexpr int NU = 512;
    const int tid = fresh_tid(wave);
    const int per = (NU + G - 1) / G, u0 = vcu * per, u1 = (u0 + per < NU) ? u0 + per : NU;
    ATT_LAS float* lut = (ATT_LAS float*)(lds + LDS_LUT);
    for (int i = tid; i < 8 * LUTW; i += NW * 64) lut[i] = T.lut[i];
    if (u0 >= u1) { __syncthreads(); return; }
    PhaseConst pc; pc.skv = 4096 >> dl; pc.ostr = 1024 << dl; pc.lstr = 8 << dl; pc.gq = T.gq;
    Seam S;
    BlockRef cur = unit_ref(T, u0, dl);
    swa_prime(cur, lds, S, tid);
    for (int u = u0; u < u1; ++u) {
        const bool last = (u + 1 >= u1);
        const BlockRef nxt = last ? cur : unit_ref(T, u + 1, dl);
        swa_block(cur, nxt, pc, lds, S, tid);
        cur = nxt;
    }
}
#undef KSWZ
#undef SBAR
}

namespace hg {
#define HG_LAS __attribute__((address_space(3)))
typedef unsigned short bf16_t;
typedef short bf16x8 __attribute__((ext_vector_type(8)));
typedef short v4i16_t __attribute__((ext_vector_type(4)));
typedef float f32x4 __attribute__((ext_vector_type(4)));
typedef unsigned u32x4 __attribute__((ext_vector_type(4)));
typedef unsigned u32x2 __attribute__((ext_vector_type(2)));
typedef HG_LAS char* lptr;
constexpr int CH = 32;
constexpr int QST = 272, KST = 288;
constexpr int OFF_QB = 0, OFF_KD = CH * QST, OFF_KE = 2 * CH * QST, OFF_V = OFF_KE + CH * KST, OFF_DEC = OFF_V + CH * KST, STAGE = OFF_DEC + 2 * 512;
constexpr int OST_ROW = 528, OSTAGE = CH * OST_ROW, OFF_OST = 2 * STAGE, LDS_BYTES = OFF_OST + 2 * OSTAGE;
constexpr float EPS = 1e-6f;
typedef float f32x2_t __attribute__((ext_vector_type(2))); typedef __bf16 bf16x2_t __attribute__((ext_vector_type(2)));
__device__ __forceinline__ unsigned cvtpk(float lo, float hi) { f32x2_t v = {lo, hi}; bf16x2_t b = __builtin_convertvector(v, bf16x2_t); return __builtin_bit_cast(unsigned, b); }
__device__ __forceinline__ u32x2 trrd(lptr p) { return __builtin_bit_cast(u32x2, __builtin_amdgcn_ds_read_tr16_b64_v4i16((HG_LAS v4i16_t*)p)); }
__device__ __forceinline__ float dpp_sum16(float v) {
    v += __builtin_bit_cast(float, __builtin_amdgcn_update_dpp(0, __builtin_bit_cast(int, v), 0xB1, 0xF, 0xF, false));
    v += __builtin_bit_cast(float, __builtin_amdgcn_update_dpp(0, __builtin_bit_cast(int, v), 0x4E, 0xF, 0xF, false));
    v += __builtin_bit_cast(float, __builtin_amdgcn_update_dpp(0, __builtin_bit_cast(int, v), 0x141, 0xF, 0xF, false));
    v += __builtin_bit_cast(float, __builtin_amdgcn_update_dpp(0, __builtin_bit_cast(int, v), 0x140, 0xF, 0xF, false));
    return v;
}
struct Tensors { const bf16_t* QB; const bf16_t* KD; const bf16_t* KE; const float* DEC; const bf16_t* V; const bf16_t* SG; const float* gn; bf16_t* OUT; };
struct Stage { u32x4 qb, kd, ke, v, dec; };
template <bool STATE_ONLY>
__device__ __forceinline__ void scan_seq(lptr lds, const Tensors& T, int tok0, int ntok, int h, int tid, float* Sio, float* Pio) {
    const int wid = __builtin_amdgcn_readfirstlane(tid >> 6), lane = tid & 63, c = lane & 15, g = lane >> 4;
    const int srow = tid >> 4, sc16 = tid & 15;
    const unsigned gofs = (unsigned)(srow * 2048 + h * 256 + sc16 * 16);
    const unsigned dofs = (unsigned)((tid >> 5) * 4096 + h * 512 + (tid & 31) * 16);
    const int lq = srow * QST + sc16 * 16, lk = srow * KST + sc16 * 16, ld = (tid >> 5) * 512 + (tid & 31) * 16;
    const int rq = OFF_QB + c * QST + g * 8, rkd = OFF_KD + c * QST + g * 8;
    const int rtr = (4 * g + (c >> 2)) * KST + (c & 3) * 8;
    const int rdec = OFF_DEC + g * 16;
    const int wost = (4 * g) * OST_ROW + (16 * wid + c) * 4;
    const int nrow = tid >> 4, n16 = tid & 15;
    const f32x4 gn0 = *(const f32x4*)(T.gn + 8 * n16), gn1 = *(const f32x4*)(T.gn + 8 * n16 + 4);
    f32x4 S[8], P[8];
    float* const sio = Sio + (4 * g) * 128 + 16 * wid + c;
#pragma unroll
    for (int kt = 0; kt < 8; ++kt) {
        if (STATE_ONLY) { S[kt] = (f32x4){0.f, 0.f, 0.f, 0.f}; P[kt] = (f32x4){1.f, 1.f, 1.f, 1.f}; }
        else {
#pragma unroll
            for (int r = 0; r < 4; ++r) S[kt][r] = sio[(16 * kt + r) * 128]; } }
    Stage st;
#define HG_LOAD(tk) do { const size_t cb = (size_t)(tk) * 2048; \
        if (!STATE_ONLY) { st.qb = *(const u32x4*)((const char*)T.QB + cb + gofs); st.kd = *(const u32x4*)((const char*)T.KD + cb + gofs); } \
        st.ke = *(const u32x4*)((const char*)T.KE + cb + gofs); st.v = *(const u32x4*)((const char*)T.V + cb + gofs); \
        if (tid < 64) st.dec = *(const u32x4*)((const char*)T.DEC + (size_t)((tk) >> 4) * 4096 + dofs); } while (0)
#define HG_WRITE(buf) do { lptr sb_ = lds + (buf) * STAGE; \
        if (!STATE_ONLY) { *(HG_LAS u32x4*)(sb_ + OFF_QB + lq) = st.qb; *(HG_LAS u32x4*)(sb_ + OFF_KD + lq) = st.kd; } *(HG_LAS u32x4*)(sb_ + OFF_KE + lk) = st.ke; *(HG_LAS u32x4*)(sb_ + OFF_V + lk) = st.v; \
        if (tid < 64) *(HG_LAS u32x4*)(sb_ + OFF_DEC + ld) = st.dec; } while (0)
#define HG_NORM(tk, ob) do { const HG_LAS f32x4* op_ = (const HG_LAS f32x4*)(lds + OFF_OST + (ob) * OSTAGE + nrow * OST_ROW + n16 * 32); \
        const f32x4 a_ = op_[0], b_ = op_[1]; const size_t ro_ = ((size_t)((tk) + nrow) * 1024 + h * 128 + 8 * n16) * 2; \
        const u32x4 sg_ = *(const u32x4*)((const char*)T.SG + ro_); \
        float ss_ = (a_[0] * a_[0] + a_[1] * a_[1]) + (a_[2] * a_[2] + a_[3] * a_[3]) + (b_[0] * b_[0] + b_[1] * b_[1]) + (b_[2] * b_[2] + b_[3] * b_[3]); \
        const float rs_ = __builtin_amdgcn_rsqf(dpp_sum16(ss_) * (1.0f / 128.0f) + EPS); \
        const f32x4 x_ = a_ * gn0 * rs_, y_ = b_ * gn1 * rs_; u32x4 w_; \
        w_[0] = cvtpk(x_[0] * __builtin_bit_cast(float, sg_[0] << 16), x_[1] * __builtin_bit_cast(float, sg_[0] & 0xffff0000u)); \
        w_[1] = cvtpk(x_[2] * __builtin_bit_cast(float, sg_[1] << 16), x_[3] * __builtin_bit_cast(float, sg_[1] & 0xffff0000u)); \
        w_[2] = cvtpk(y_[0] * __builtin_bit_cast(float, sg_[2] << 16), y_[1] * __builtin_bit_cast(float, sg_[2] & 0xffff0000u)); \
        w_[3] = cvtpk(y_[2] * __builtin_bit_cast(float, sg_[3] << 16), y_[3] * __builtin_bit_cast(float, sg_[3] & 0xffff0000u)); \
        *(u32x4*)((char*)T.OUT + ro_) = w_; } while (0)
    const int nch = ntok / CH;
    HG_LOAD(tok0); HG_WRITE(0);
    __syncthreads();
    for (int ci = 0; ci < nch; ++ci) {
        const int tk = tok0 + ci * CH, buf = ci & 1;
        if (ci + 1 < nch) HG_LOAD(tk + CH);
        lptr sb = lds + buf * STAGE; lptr ob = lds + OFF_OST + buf * OSTAGE;
#pragma unroll
        for (int j = 0; j < 2; ++j) {
            const u32x2 vt = trrd(sb + OFF_V + rtr + j * 16 * KST + wid * 32);
            const bf16x8 vb = __builtin_bit_cast(bf16x8, (u32x4){vt[0], vt[1], 0u, 0u});
            if (!STATE_ONLY) {
                bf16x8 qf[4], kf[4];
#pragma unroll
                for (int kk = 0; kk < 4; ++kk) {
                    const u32x2 q0 = *(const HG_LAS u32x2*)(sb + rq + j * 16 * QST + kk * 64), q1 = *(const HG_LAS u32x2*)(sb + rq + j * 16 * QST + kk * 64 + 32);
                    const u32x2 k0 = *(const HG_LAS u32x2*)(sb + rkd + j * 16 * QST + kk * 64), k1 = *(const HG_LAS u32x2*)(sb + rkd + j * 16 * QST + kk * 64 + 32);
                    qf[kk] = __builtin_bit_cast(bf16x8, (u32x4){q0[0], q0[1], q1[0], q1[1]}); kf[kk] = __builtin_bit_cast(bf16x8, (u32x4){k0[0], k0[1], k1[0], k1[1]}); }
                f32x4 at = {0.f, 0.f, 0.f, 0.f};
#pragma unroll
                for (int kk = 0; kk < 4; ++kk) at = __builtin_amdgcn_mfma_f32_16x16x32_bf16(kf[kk], qf[kk], at, 0, 0, 0);
#pragma unroll
                for (int r = 0; r < 4; ++r) at[r] = (4 * g + r <= c) ? at[r] : 0.f;
                const bf16x8 pa = __builtin_bit_cast(bf16x8, (u32x4){cvtpk(at[0], at[1]), cvtpk(at[2], at[3]), 0u, 0u});
                f32x4 o = __builtin_amdgcn_mfma_f32_16x16x32_bf16(pa, vb, (f32x4){0.f, 0.f, 0.f, 0.f}, 0, 0, 0);
#pragma unroll
                for (int kk = 0; kk < 4; ++kk) {
                    const bf16x8 sbf = __builtin_bit_cast(bf16x8, (u32x4){cvtpk(S[2 * kk][0], S[2 * kk][1]), cvtpk(S[2 * kk][2], S[2 * kk][3]), cvtpk(S[2 * kk + 1][0], S[2 * kk + 1][1]), cvtpk(S[2 * kk + 1][2], S[2 * kk + 1][3])});
                    o = __builtin_amdgcn_mfma_f32_16x16x32_bf16(qf[kk], sbf, o, 0, 0, 0); }
#pragma unroll
                for (int r = 0; r < 4; ++r) *(HG_LAS float*)(ob + wost + (j * 16 + r) * OST_ROW) = o[r];
            }
#pragma unroll
            for (int kt = 0; kt < 8; ++kt) {
                const f32x4 d4 = *(const HG_LAS f32x4*)(sb + rdec + j * 512 + kt * 64);
                const u32x2 kt2 = trrd(sb + OFF_KE + rtr + j * 16 * KST + kt * 32);
                const bf16x8 ka = __builtin_bit_cast(bf16x8, (u32x4){kt2[0], kt2[1], 0u, 0u});
                if (STATE_ONLY) P[kt] = P[kt] * d4;
                S[kt] = __builtin_amdgcn_mfma_f32_16x16x32_bf16(ka, vb, S[kt] * d4, 0, 0, 0); }
        }
        if (!STATE_ONLY && ci > 0) HG_NORM(tk - CH, buf ^ 1);
        if (ci + 1 < nch) HG_WRITE(buf ^ 1);
        __syncthreads();
    }
    if (!STATE_ONLY) HG_NORM(tok0 + (nch - 1) * CH, (nch - 1) & 1);
    else {
#pragma unroll
        for (int kt = 0; kt < 8; ++kt) {
#pragma unroll
            for (int r = 0; r < 4; ++r) sio[(16 * kt + r) * 128] = S[kt][r];
            if (wid == 0 && c == 0) *(f32x4*)(Pio + 16 * kt + 4 * g) = P[kt]; }
    }
    __syncthreads();
#undef HG_LOAD
#undef HG_WRITE
#undef HG_NORM
}
__device__ __forceinline__ void scan_combine(float* Sall, const float* Pall, int nbh, int nsc, int gtid, int nthr) {
    for (int i = gtid; i < nbh * 4096; i += nthr) { const int bh = i >> 12, e4 = i & 4095, k = e4 >> 5;
        f32x4* sp = (f32x4*)(Sall + (size_t)bh * nsc * 16384) + e4; const float* pp = Pall + (size_t)bh * nsc * 128 + k;
        f32x4 t[8]; float pk[8];
#pragma unroll
        for (int s = 0; s < 8; ++s) { t[s] = sp[(size_t)s * 4096]; pk[s] = pp[s * 128]; }
        f32x4 r = {0.f, 0.f, 0.f, 0.f};
#pragma unroll
        for (int s = 0; s < 8; ++s) { sp[(size_t)s * 4096] = r; r = r * pk[s] + t[s]; } }
}
}

constexpr int NWAVES = 8;
constexpr int NB = 4, SEQ = 4096, D = 1024, M = NB * SEQ, NH = 8, HD = 128, NG = 3, FF = 2816, NUP = 2 * FF;
constexpr float RMS_EPS = 1e-6f, ATT_SCALE = 0.08838834764831845f;
constexpr size_t MiB = 1u << 20;
constexpr size_t WS_CTL = 0, CTL_ZERO_BYTES = 1 * MiB;
constexpr size_t WS_MOD = 1 * MiB;
constexpr size_t WS_LBS = 1 * MiB + 256 * 1024;
constexpr size_t WS_LUT = 1 * MiB + 320 * 1024;
constexpr size_t WS_ML = 2 * MiB;
constexpr size_t WS_LUT2 = 1 * MiB + 384 * 1024;
constexpr size_t WS_GQ = 1 * MiB + 448 * 1024;
constexpr size_t WS_HGP = 4 * MiB;
constexpr size_t WS_WQKV = 8 * MiB, WS_WO = 26 * MiB, WS_W13_0 = 28 * MiB, WS_W2_0 = 39 * MiB;
constexpr size_t WS_WIN = 44 * MiB + 512 * 1024, WS_WHO = WS_WIN + 8 * MiB, WS_W13_1 = WS_WHO + 2 * MiB, WS_W2_1 = WS_W13_1 + 11 * MiB;
constexpr size_t WS_SG = 8 * MiB;
constexpr size_t WS_ACT = 72 * MiB;
constexpr size_t WS_BIG = 104 * MiB;
constexpr size_t WS_R2 = 200 * MiB;
constexpr size_t WS_END = 256 * MiB;
constexpr size_t QKV_STRIDE = (size_t)NB * NH * SEQ * HD;
constexpr int LUT_N = 129;
constexpr int CW_BAR = 4096;
constexpr int RING_BYTES = 131072, LDSCTL_OFF = RING_BYTES, MISC_OFF = LDSCTL_OFF + 320, LDS_BYTES = 147456;

struct Args { const float* in[18]; float* out; unsigned char* ws; int ph_lo, ph_hi; };
struct Frame {
    LAS unsigned char* lds; volatile LAS unsigned* MISC; gu32* ctl;
    int wave, vcu, G;
};

typedef const __attribute__((address_space(4))) Args* kargs_t;
__device__ __forceinline__ kargs_t kargs() { kargs_t p = (kargs_t)__builtin_amdgcn_kernarg_segment_ptr(); asm volatile("" : "+s"(p)); return p; }
__device__ __forceinline__ float bf2f(unsigned short h) { return __builtin_bit_cast(float, (unsigned)h << 16); }
__device__ __forceinline__ float bflo(unsigned w) { return __builtin_bit_cast(float, w << 16); }
__device__ __forceinline__ float bfhi(unsigned w) { return __builtin_bit_cast(float, w & 0xffff0000u); }
__device__ __forceinline__ float wave_sum(float v) {
#pragma unroll
    for (int o = 1; o < 64; o <<= 1) v += __shfl_xor(v, o);
    return v;
}
__device__ __forceinline__ void tr_item(const float* W, int Nsrc, int K, bf16* WT, int k0, int n0s, int drow0, LAS float* scr, int lane) {
#pragma unroll 8
    for (int i = 0; i < 32; ++i) { const int kk = 2 * i + (lane >> 5); scr[kk * 33 + (lane & 31)] = W[(size_t)(k0 + kk) * Nsrc + n0s + (lane & 31)]; }
    LDS_WAIT(); asm volatile("" ::: "memory");
    const int c = lane & 7;
#pragma unroll
    for (int j = 0; j < 4; ++j) { const int n = (lane >> 3) + 8 * j; const LAS float* s = scr + (8 * c) * 33 + n;
        v4u o; o.x = pk2(s[0 * 33], s[1 * 33]); o.y = pk2(s[2 * 33], s[3 * 33]); o.z = pk2(s[4 * 33], s[5 * 33]); o.w = pk2(s[6 * 33], s[7 * 33]);
        *(GAS v4u*)(WT + (size_t)(drow0 + n) * K + k0 + 8 * c) = o; }
    LDS_WAIT(); asm volatile("" ::: "memory");
}
__device__ __forceinline__ int t5_bucket(int n) {
    if (n < 16) return n;
    int v = 16 + (int)(log((double)n / 16.0) / log(128.0) * 16.0);
    return v > 31 ? 31 : v;
}
__device__ __forceinline__ void p0_prologue(Frame& F) {
    const int ptid = fresh_tid(F.wave), plane = ptid & 63;
    const kargs_t A = kargs(); unsigned char* const ws = A->ws;
    if (F.vcu < 48) {
        LAS float* cact = (LAS float*)F.lds;
        LAS float* red = (LAS float*)(F.lds + 16384);
        for (int i = ptid; i < 4096; i += NWAVES * 64) { const float c = A->in[1][i]; cact[i] = c * __builtin_amdgcn_rcpf(1.0f + __expf(-c)); }
        __syncthreads();
        const int l = F.vcu / 24, cg = F.vcu % 24;
        const float* wp = A->in[3] + (size_t)l * 1024 * 6144 + (size_t)(F.wave * 128) * 6144 + cg * 256 + plane * 4;
        f32x4 a0 = {0.f, 0.f, 0.f, 0.f}, a1 = a0, a2 = a0, a3 = a0;
#pragma unroll 8
        for (int k = 0; k < 128; ++k) { const f32x4 wv = *(const f32x4*)(wp + (size_t)k * 6144); const int kk = F.wave * 128 + k;
            a0 += wv * cact[kk]; a1 += wv * cact[1024 + kk]; a2 += wv * cact[2048 + kk]; a3 += wv * cact[3072 + kk]; }
        LAS f32x4* r4 = (LAS f32x4*)red + F.wave * 256;
        r4[plane] = a0; r4[64 + plane] = a1; r4[128 + plane] = a2; r4[192 + plane] = a3;
        __syncthreads();
        float* mod = (float*)(ws + WS_MOD);
        for (int idx = ptid; idx < 1024; idx += NWAVES * 64) { const int b = idx >> 8, col = idx & 255; float s = 0.f;
#pragma unroll
            for (int w = 0; w < 8; ++w) s += red[(w * 4 + b) * 256 + col];
            mod[(size_t)(l * 4 + b) * 6144 + cg * 256 + col] = s + A->in[4][l * 6144 + cg * 256 + col]; }
        __syncthreads();
    } else if (F.vcu == 48) {
        float* lbs = (float*)(ws + WS_LBS);
        for (int k = ptid; k < 1024; k += NWAVES * 64) { const float b0 = A->in[14][k], b1 = A->in[14][1024 + k]; lbs[k] = 1.0f / (1.0f + expf(b0 - b1)); }
    } else if (F.vcu == 49) {
        float* lut = (float*)(ws + WS_LUT);
        for (int i = ptid; i < NG * NH * LUT_N; i += NWAVES * 64) { const int j = i % LUT_N, gh = i / LUT_N, g = gh >> 3;
            lut[i] = A->in[2][t5_bucket(j << (2 * g)) * (NG * NH) + gh]; }
        float* lut2 = (float*)(ws + WS_LUT2);
        for (int i = ptid; i < NG * NH * att::LUTW; i += NWAVES * 64) { const int j = i % att::LUTW - att::LUT_OFF, gh = i / att::LUTW, g = gh >> 3;
            lut2[i] = (j >= 0 && j <= 128) ? A->in[2][t5_bucket(j << (2 * g)) * (NG * NH) + gh] * (1.0f / ATT_SCALE) : 0.f; }
        float* gq = (float*)(ws + WS_GQ);
        for (int i = ptid; i < NG * 128; i += NWAVES * 64) gq[i] = A->in[9][i] * A->in[10][i];
    }
    LAS float* scr = (LAS float*)(F.lds + F.wave * 16384);
    const int gw = F.vcu * NWAVES + F.wave, NGW = F.G * NWAVES;
    constexpr int I_QKV = 16 * 288, I_SQ = 16 * 32, I_UP = 16 * 88, I_DN = 44 * 32, I_IN = 16 * 128;
    constexpr int NITEMS = I_QKV + I_SQ + 2 * I_UP + I_DN + I_IN + I_SQ + 2 * I_UP + I_DN;
    for (int it = gw; it < NITEMS; it += NGW) {
        int r = it;
        if (r < I_QKV) { const int kb = r / 288, nb = r % 288; tr_item(A->in[7], 9216, 1024, (bf16*)(ws + WS_WQKV), 64 * kb, 32 * nb, 32 * nb, scr, plane); continue; } r -= I_QKV;
        if (r < I_SQ) { const int kb = r / 32, nb = r % 32; tr_item(A->in[8], 1024, 1024, (bf16*)(ws + WS_WO), 64 * kb, 32 * nb, 32 * nb, scr, plane); continue; } r -= I_SQ;
        if (r < I_IN) { const int kb = r / 128, nb = r % 128;
            const int seg = nb >> 5, hh = (nb >> 2) & 7, sub = nb & 3;
            tr_item(A->in[11], 4096, 1024, (bf16*)(ws + WS_WIN), 64 * kb, 32 * nb, 256 * (2 * hh + (seg >> 1)) + 128 * (seg & 1) + 32 * sub, scr, plane); continue; } r -= I_IN;
        if (r < I_SQ) { const int kb = r / 32, nb = r % 32; tr_item(A->in[12], 1024, 1024, (bf16*)(ws + WS_WHO), 64 * kb, 32 * nb, 32 * nb, scr, plane); continue; } r -= I_SQ;
        const int l = r / (2 * I_UP + I_DN); r -= l * (2 * I_UP + I_DN);
        if (r < 2 * I_UP) { const int which = r / I_UP, rr = r % I_UP, kb = rr / 88, nb = rr % 88;
            tr_item((which ? A->in[16] : A->in[15]) + (size_t)l * 1024 * FF, FF, 1024, (bf16*)(ws + (l ? WS_W13_1 : WS_W13_0)), 64 * kb, 32 * nb, 256 * (nb >> 2) + 128 * which + 32 * (nb & 3), scr, plane); continue; } r -= 2 * I_UP;
        { const int kb = r / 32, nb = r % 32; tr_item(A->in[17] + (size_t)l * FF * 1024, 1024, FF, (bf16*)(ws + (l ? WS_W2_1 : WS_W2_0)), 64 * kb, 32 * nb, 32 * nb, scr, plane); }
    }
}
__device__ __forceinline__ void norm_mod_pass(Frame& F, const float* x, const float* gain, const float* sh, const float* sc) {
    const int ptid = fresh_tid(F.wave), plane = ptid & 63;
    unsigned char* const ws = kargs()->ws;
    const int gw = F.vcu * NWAVES + F.wave, NGW = F.G * NWAVES;
    bf16* act = (bf16*)(ws + WS_ACT);
    for (int r0 = gw * 8; r0 < M; r0 += NGW * 8) {
        const int b = r0 >> 12;
        f32x4 gam[4], shv[4];
#pragma unroll
        for (int j = 0; j < 4; ++j) { const int c = 4 * plane + 256 * j; const f32x4 gn = *(const f32x4*)(gain + c), s = *(const f32x4*)(sc + b * 6144 + c);
            gam[j] = gn * (s + 1.0f); shv[j] = *(const f32x4*)(sh + b * 6144 + c); }
#pragma unroll 1
        for (int rr = 0; rr < 8; rr += 2) {
            f32x4 v[2][4];
#pragma unroll
            for (int q = 0; q < 2; ++q)
#pragma unroll
                for (int j = 0; j < 4; ++j) v[q][j] = *(const GAS f32x4*)(x + (size_t)(r0 + rr + q) * D + 4 * plane + 256 * j);
#pragma unroll
            for (int q = 0; q < 2; ++q) { float s = 0.f;
#pragma unroll
                for (int j = 0; j < 4; ++j) s += (v[q][j].x * v[q][j].x + v[q][j].y * v[q][j].y) + (v[q][j].z * v[q][j].z + v[q][j].w * v[q][j].w);
                const float rstd = 1.0f / sqrtf(wave_sum(s) * (1.0f / D) + RMS_EPS);
                GAS unsigned long long* o8 = (GAS unsigned long long*)(act + (size_t)(r0 + rr + q) * D) + plane;
#pragma unroll
                for (int j = 0; j < 4; ++j) { const f32x4 o = v[q][j] * rstd * gam[j] + shv[j];
                    o8[64 * j] = (unsigned long long)pk2(o.x, o.y) | ((unsigned long long)pk2(o.z, o.w) << 32); } }
        }
    }
}
__device__ __forceinline__ void attn_naive(Frame& F, int g) {
    const int ptid = fresh_tid(F.wave), plane = ptid & 63;
    const kargs_t A = kargs(); unsigned char* const ws = A->ws; float* const outp = A->out;
    const int dl = 2 * g, dmask = (1 << dl) - 1, Lsub = SEQ >> dl;
    const bf16* Q = (const bf16*)(ws + WS_BIG); const bf16* K = Q + QKV_STRIDE; const bf16* V = K + QKV_STRIDE;
    float* ML = (float*)(ws + WS_ML); float* orun = outp; bf16* act = (bf16*)(ws + WS_ACT);
    const float* lut = (const float*)(ws + WS_LUT);
    const int l2 = 2 * plane;
    const float qk0 = A->in[9][g * 128 + l2] * A->in[10][g * 128 + l2], qk1 = A->in[9][g * 128 + l2 + 1] * A->in[10][g * 128 + l2 + 1];
    const int gw = F.vcu * NWAVES + F.wave, NGW = F.G * NWAVES;
    for (int item = gw; item < M * NH; item += NGW) {
        const int row = item >> 3, h = item & 7, b = row >> 12, t = row & 4095, r = t & dmask, mi = t >> dl;
        const size_t hb = ((size_t)(b * 8 + h) * SEQ + (size_t)r * Lsub) * HD;
        const unsigned qw = *(const GAS unsigned*)(Q + hb + (size_t)mi * HD + l2);
        float q0 = bflo(qw), q1 = bfhi(qw);
        const float rq = 1.0f / sqrtf(wave_sum(q0 * q0 + q1 * q1) * (1.0f / HD) + RMS_EPS);
        q0 *= rq * qk0; q1 *= rq * qk1;
        float m = -1e30f, l = 0.f, o0 = 0.f, o1 = 0.f;
        if (g > 0) { m = ML[(size_t)item * 2]; l = ML[(size_t)item * 2 + 1]; o0 = orun[(size_t)row * D + h * HD + l2]; o1 = orun[(size_t)row * D + h * HD + l2 + 1]; }
        const float* bl = lut + (g * 8 + h) * LUT_N;
        const int nj = mi < 128 ? mi : 128;
        for (int j = 0; j <= nj; ++j) {
            const size_t ko = hb + (size_t)(mi - j) * HD + l2;
            const unsigned kw = *(const GAS unsigned*)(K + ko), vw = *(const GAS unsigned*)(V + ko);
            const float k0 = bflo(kw), k1 = bfhi(kw);
            float a = q0 * k0 + q1 * k1, s2 = k0 * k0 + k1 * k1;
#pragma unroll
            for (int o = 1; o < 64; o <<= 1) { a += __shfl_xor(a, o); s2 += __shfl_xor(s2, o); }
            const float s = a * (1.0f / sqrtf(s2 * (1.0f / HD) + RMS_EPS)) * ATT_SCALE + bl[j];
            const float mn = fmaxf(m, s), al = __expf(m - mn), p = __expf(s - mn);
            l = l * al + p; o0 = o0 * al + p * bflo(vw); o1 = o1 * al + p * bfhi(vw); m = mn;
        }
        if (g < 2) { if (plane == 0) { ML[(size_t)item * 2] = m; ML[(size_t)item * 2 + 1] = l; }
            orun[(size_t)row * D + h * HD + l2] = o0; orun[(size_t)row * D + h * HD + l2 + 1] = o1; }
        else { const float il = 1.0f / l; *(GAS unsigned*)(act + (size_t)row * D + h * HD + l2) = pk2(o0 * il, o1 * il); }
    }
}
__device__ __forceinline__ void merge_pass(Frame& F) {
    const int ptid = fresh_tid(F.wave), plane = ptid & 63;
    const kargs_t A = kargs(); unsigned char* const ws = A->ws;
    const bf16* O0 = (const bf16*)A->out; const bf16* O1 = O0 + (size_t)M * D; const bf16* O2 = (const bf16*)(ws + WS_R2);
    const float* L = (const float*)(ws + WS_ML); bf16* act = (bf16*)(ws + WS_ACT);
    const int gw = F.vcu * NWAVES + F.wave, NGW = F.G * NWAVES, head = plane >> 3;
    for (int r0 = gw * 8; r0 < M; r0 += NGW * 8) {
#pragma unroll 2
        for (int rr = 0; rr < 8; ++rr) { const size_t row = (size_t)(r0 + rr), off = row * D + 16 * plane;
            const float l0 = L[row * 8 + head], l1 = L[(size_t)M * 8 + row * 8 + head], l2 = L[(size_t)2 * M * 8 + row * 8 + head];
            const v4u a0 = *(const GAS v4u*)(O0 + off), a1 = *(const GAS v4u*)(O0 + off + 8), b0 = *(const GAS v4u*)(O1 + off), b1 = *(const GAS v4u*)(O1 + off + 8), c0 = *(const GAS v4u*)(O2 + off), c1 = *(const GAS v4u*)(O2 + off + 8);
            const float mx = fmaxf(l0, fmaxf(l1, l2));
            float w0 = __builtin_amdgcn_exp2f(l0 - mx), w1 = __builtin_amdgcn_exp2f(l1 - mx), w2 = __builtin_amdgcn_exp2f(l2 - mx);
            const float inv = 1.0f / (w0 + w1 + w2); w0 *= inv; w1 *= inv; w2 *= inv;
            v4u o0, o1;
#pragma unroll
            for (int i = 0; i < 4; ++i) {
                o0[i] = pk2(w0 * bflo(a0[i]) + w1 * bflo(b0[i]) + w2 * bflo(c0[i]), w0 * bfhi(a0[i]) + w1 * bfhi(b0[i]) + w2 * bfhi(c0[i]));
                o1[i] = pk2(w0 * bflo(a1[i]) + w1 * bflo(b1[i]) + w2 * bflo(c1[i]), w0 * bfhi(a1[i]) + w1 * bfhi(b1[i]) + w2 * bfhi(c1[i])); }
            *(GAS v4u*)(act + off) = o0; *(GAS v4u*)(act + off + 8) = o1; }
    }
}
__device__ __forceinline__ void hgrn_naive(Frame& F) {
    const int ptid = fresh_tid(F.wave), plane = ptid & 63;
    if (F.vcu >= NB * NH) return;
    const kargs_t A = kargs(); unsigned char* const ws = A->ws;
    const int b = F.vcu >> 3, h = F.vcu & 7, kq = F.wave >> 1, v = 64 * (F.wave & 1) + plane;
    const bf16* QS = (const bf16*)(ws + WS_BIG); const float* FG = (const float*)(ws + WS_BIG + 32 * MiB);
    const bf16* V = (const bf16*)(ws + WS_R2); const bf16* SG = (const bf16*)(ws + WS_SG); bf16* act = (bf16*)(ws + WS_ACT);
    LAS float* po = (LAS float*)F.lds;
    float S[32];
#pragma unroll
    for (int j = 0; j < 32; ++j) S[j] = 0.f;
    const int tt2 = ptid >> 5, l32 = ptid & 31;
    const f32x4 gn = *(const f32x4*)(A->in[13] + 4 * l32);
    for (int t0 = 0; t0 < SEQ; t0 += 16) {
        for (int tt = 0; tt < 16; ++tt) {
            const size_t ro = (size_t)(b * SEQ + t0 + tt) * D + h * HD;
            const float iv = bf2f(V[ro + v]);
            const float* fgp = FG + ro + 32 * kq; const bf16* qp = QS + ro + 32 * kq;
            float acc = 0.f;
#pragma unroll
            for (int j4 = 0; j4 < 8; ++j4) { const f32x4 f4 = *(const f32x4*)(fgp + 4 * j4); const unsigned long long q4 = *(const unsigned long long*)(qp + 4 * j4);
#pragma unroll
                for (int i = 0; i < 4; ++i) { const float fg = f4[i], qv = bf2f((unsigned short)(q4 >> (16 * i)));
                    S[4 * j4 + i] = fg * S[4 * j4 + i] + (1.0f - fg) * iv; acc += qv * S[4 * j4 + i]; } }
            po[(tt * 4 + kq) * 128 + v] = acc;
        }
        __syncthreads();
        { const size_t ro = (size_t)(b * SEQ + t0 + tt2) * D + h * HD + 4 * l32;
          const LAS f32x4* p4 = (const LAS f32x4*)po + (tt2 * 4) * 32 + l32;
          const f32x4 o = (p4[0] + p4[32]) + (p4[64] + p4[96]);
          float ss = (o.x * o.x + o.y * o.y) + (o.z * o.z + o.w * o.w);
#pragma unroll
          for (int sft = 1; sft < 32; sft <<= 1) ss += __shfl_xor(ss, sft);
          const float rstd = 1.0f / sqrtf(ss * (1.0f / HD) + RMS_EPS);
          const unsigned long long sg = *(const unsigned long long*)(SG + ro);
          const f32x4 r = o * rstd * gn;
          const unsigned lo = pk2(r.x * bf2f((unsigned short)sg), r.y * bf2f((unsigned short)(sg >> 16))), hi = pk2(r.z * bf2f((unsigned short)(sg >> 32)), r.w * bf2f((unsigned short)(sg >> 48)));
          *(GAS unsigned long long*)(act + ro) = (unsigned long long)lo | ((unsigned long long)hi << 32); }
        __syncthreads();
    }
}

constexpr int NPHASE = 22;
#ifndef NAIVE_ATTN
#define NAIVE_ATTN 0
#endif
#ifndef NAIVE_HGRN
#define NAIVE_HGRN 0
#endif
__global__ void __launch_bounds__(NWAVES * 64, 2) mk_fwd(Args args) {
    extern __shared__ __attribute__((aligned(16))) unsigned char lds[];
    Frame F;
    F.lds = (LAS unsigned char*)lds; F.MISC = (volatile LAS unsigned*)(F.lds + MISC_OFF);
    F.wave = __builtin_amdgcn_readfirstlane((int)threadIdx.x >> 6);
    F.G = gridDim.x; { const int bx = blockIdx.x; F.vcu = (F.G % 8 == 0) ? (bx % 8) * (F.G / 8) + bx / 8 : bx; }
    F.ctl = (gu32*)(args.ws + WS_CTL);
    for (int u = fresh_tid(F.wave); u < (LDS_BYTES - LDSCTL_OFF) / 4; u += NWAVES * 64) ((LAS unsigned*)(F.lds + LDSCTL_OFF))[u] = 0u;
    __syncthreads();
    const int lo = args.ph_lo, hi = args.ph_hi;
    const bool multi = (hi - lo) > 1;
    XcdBarrier bar; bar.bar = (unsigned*)(F.ctl + CW_BAR); bar.x = 0; bar.st = nullptr; bar.wave = F.wave;
    if (multi) bar = xcd_barrier_post((unsigned*)(F.ctl + CW_BAR), F.MISC + 8, F.wave);
#ifndef PH_MASK
#define PH_MASK 0xFFFFFFFFu
#endif
#define IN(k) (((PH_MASK >> (k)) & 1u) && lo <= (k) && (k) < hi)
#define SEAM(k) do { if (IN(k) && IN((k) + 1)) xcd_barrier(bar); } while (0)
#define PHASE_PTRS const kargs_t A = kargs(); unsigned char* const ws = A->ws; float* const outp = A->out; float* const mod = (float*)(ws + WS_MOD); bf16* const act = (bf16*)(ws + WS_ACT); (void)outp; (void)mod; (void)act
    enum { P_PRO = 0, P_XN0 = 1, P_QKV = 2  , P_ATT = 3  , P_MRG = 8, P_WO = 9, P_XNF0 = 10, P_UP0 = 11, P_DN0 = 12, P_XN1 = 13, P_HIN = 14, P_SCAN = 15, P_SCANB = 16, P_SCANC = 17, P_HOUT = 18, P_XNF1 = 19, P_UP1 = 20, P_DN1 = 21 };
    if (IN(P_PRO)) { p0_prologue(F); } SEAM(P_PRO);
    if (IN(P_XN0)) { PHASE_PTRS; norm_mod_pass(F, A->in[0], A->in[5], mod + 0, mod + 1024); } SEAM(P_XN0);
#if NAIVE_ATTN
#define ATT_GROUP(g) if (IN(P_ATT + 2 * (g))) { attn_naive(F, (g)); } SEAM(P_ATT + 2 * (g));
#else
#define ATT_GROUP(g) if (IN(P_ATT + 2 * (g))) { PHASE_PTRS; \
            att::Tensors T; T.Q = (const bf16*)(ws + WS_BIG); T.K = T.Q + QKV_STRIDE; T.V = T.K + QKV_STRIDE; \
            T.O = (g) == 2 ? (bf16*)(ws + WS_R2) : (bf16*)outp + (size_t)(g) * M * D; T.LSE = (float*)(ws + WS_ML) + (size_t)(g) * M * 8; \
            T.lut = (const float*)(ws + WS_LUT2) + (g) * 8 * att::LUTW; T.gq = (const float*)(ws + WS_GQ) + (g) * 128; \
            att::attn_phase((att::lptr)F.lds, T, 2 * (g), F.vcu, F.G, F.wave); \
        } SEAM(P_ATT + 2 * (g));
#endif
#define QKV_GROUP(g) if (IN(P_QKV + 2 * (g))) { PHASE_PTRS; \
            pg8::Gemm gm{act, (const bf16*)(ws + WS_WQKV) + (size_t)(g) * 3072 * 1024, M, 3072, 1024}; pg8::StaticOrder S; S.init(M, 3072, F.G, (int)blockIdx.x); \
            pg8::EpiQKV E{(bf16*)(ws + WS_BIG), 2 * (g)}; \
            pg8::gemm_phase<pg8::EpiQKV, pg8::StaticOrder, true, true>(F.lds, gm, S, E, F.wave); \
        } SEAM(P_QKV + 2 * (g));
    QKV_GROUP(0) ATT_GROUP(0) QKV_GROUP(1) ATT_GROUP(1) QKV_GROUP(2) ATT_GROUP(2)
#if !NAIVE_ATTN
    if (IN(P_MRG)) { merge_pass(F); }
#endif
    SEAM(P_MRG);
    if (IN(P_WO)) { PHASE_PTRS;
        pg8::Gemm gm{act, (const bf16*)(ws + WS_WO), M, 1024, 1024}; pg8::StaticOrder S; S.init(M, 1024, F.G, (int)blockIdx.x);
        pg8::EpiRes E{A->in[0], outp, mod + 2048};
        pg8::gemm_phase<pg8::EpiRes, pg8::StaticOrder, true, true>(F.lds, gm, S, E, F.wave);
    } SEAM(P_WO);
#define FFN_LAYER(l, p0) \
        if (IN(p0)) { PHASE_PTRS; float* const modl = mod + (size_t)(l) * 4 * 6144; norm_mod_pass(F, outp, A->in[6] + (l) * 1024, modl + 3072, modl + 4096); } SEAM(p0); \
        if (IN((p0) + 1)) { PHASE_PTRS; \
            pg8::Gemm gm{act, (const bf16*)(ws + ((l) ? WS_W13_1 : WS_W13_0)), M, NUP, 1024}; pg8::StaticOrder S; S.init(M, NUP, F.G, (int)blockIdx.x); \
            pg8::EpiSwiGLU E{(bf16*)(ws + WS_BIG), FF}; \
            pg8::gemm_phase<pg8::EpiSwiGLU, pg8::StaticOrder, true, true>(F.lds, gm, S, E, F.wave); \
        } SEAM((p0) + 1); \
        if (IN((p0) + 2)) { PHASE_PTRS; float* const modl = mod + (size_t)(l) * 4 * 6144; \
            pg8::Gemm gm{(const bf16*)(ws + WS_BIG), (const bf16*)(ws + ((l) ? WS_W2_1 : WS_W2_0)), M, 1024, FF}; pg8::StaticOrder S; S.init(M, 1024, F.G, (int)blockIdx.x); \
            pg8::EpiRes E{outp, outp, modl + 5120}; \
            pg8::gemm_phase<pg8::EpiRes, pg8::StaticOrder, true, true>(F.lds, gm, S, E, F.wave); \
        } SEAM((p0) + 2);
    FFN_LAYER(0, P_XNF0)
    if (IN(P_XN1)) { PHASE_PTRS; float* const mod1 = mod + (size_t)4 * 6144; norm_mod_pass(F, outp, A->in[5] + 1024, mod1 + 0, mod1 + 1024); } SEAM(P_XN1);
    if (IN(P_HIN)) { PHASE_PTRS;
        pg8::Gemm gm{act, (const bf16*)(ws + WS_WIN), M, 4096, 1024}; pg8::StaticOrder S; S.init(M, 4096, F.G, (int)blockIdx.x);
#if NAIVE_HGRN
        pg8::EpiHgrnNaive E{(bf16*)(ws + WS_BIG), (float*)(ws + WS_BIG + 32 * MiB), (bf16*)(ws + WS_R2), (bf16*)(ws + WS_SG), (const float*)(ws + WS_LBS)};
        pg8::gemm_phase<pg8::EpiHgrnNaive, pg8::StaticOrder, true, true>(F.lds, gm, S, E, F.wave);
#else
        pg8::EpiHgrn E{(bf16*)(ws + WS_BIG), (bf16*)(ws + WS_BIG + 32 * MiB), (bf16*)(ws + WS_BIG + 64 * MiB), (float*)(ws + WS_R2 + 32 * MiB), (bf16*)(ws + WS_R2), (bf16*)(ws + WS_SG), (const float*)(ws + WS_LBS)};
        pg8::gemm_phase<pg8::EpiHgrn, pg8::StaticOrder, true, true>(F.lds, gm, S, E, F.wave);
#endif
    } SEAM(P_HIN);
#if NAIVE_HGRN
    if (IN(P_SCAN)) { hgrn_naive(F); } SEAM(P_SCAN);
#else
#define HG_TENSORS hg::Tensors T; T.QB = (const bf16*)(ws + WS_BIG); T.KD = (const bf16*)(ws + WS_BIG + 32 * MiB); T.KE = (const bf16*)(ws + WS_BIG + 64 * MiB); T.DEC = (const float*)(ws + WS_R2 + 32 * MiB); \
        T.V = (const bf16*)(ws + WS_R2); T.SG = (const bf16*)(ws + WS_SG); T.gn = A->in[13]; T.OUT = act; \
        float* const Sall = (float*)(ws + WS_R2 + 36 * MiB); float* const Pall = (float*)(ws + WS_HGP)
    if (IN(P_SCAN)) { PHASE_PTRS; HG_TENSORS;
        if (F.vcu < 256) hg::scan_seq<true>((hg::lptr)F.lds, T, (F.vcu >> 6) * SEQ + (F.vcu & 7) * 512, 512, (F.vcu >> 3) & 7, fresh_tid(F.wave), Sall + (size_t)F.vcu * 16384, Pall + F.vcu * 128);
    } SEAM(P_SCAN);
    if (IN(P_SCANB)) { PHASE_PTRS; HG_TENSORS; (void)T;
        hg::scan_combine(Sall, Pall, NB * NH, 8, F.vcu * 512 + fresh_tid(F.wave), F.G * 512);
    } SEAM(P_SCANB);
    if (IN(P_SCANC)) { PHASE_PTRS; HG_TENSORS;
        if (F.vcu < 256) hg::scan_seq<false>((hg::lptr)F.lds, T, (F.vcu >> 6) * SEQ + (F.vcu & 7) * 512, 512, (F.vcu >> 3) & 7, fresh_tid(F.wave), Sall + (size_t)F.vcu * 16384, Pall + F.vcu * 128);
    } SEAM(P_SCANC);
#endif
    if (IN(P_HOUT)) { PHASE_PTRS; float* const mod1 = mod + (size_t)4 * 6144;
        pg8::Gemm gm{act, (const bf16*)(ws + WS_WHO), M, 1024, 1024}; pg8::StaticOrder S; S.init(M, 1024, F.G, (int)blockIdx.x);
        pg8::EpiRes E{outp, outp, mod1 + 2048};
        pg8::gemm_phase<pg8::EpiRes, pg8::StaticOrder, true, true>(F.lds, gm, S, E, F.wave);
    } SEAM(P_HOUT);
    FFN_LAYER(1, P_XNF1)
#undef IN
#undef SEAM
}

#ifndef MK_PER_PHASE
#define MK_PER_PHASE 0
#endif
extern "C" void kernel_launch(void* const* d_in, const int* in_sizes, int n_in, void* d_out, int out_size, void* d_ws, size_t ws_size, hipStream_t stream) {
    static int grid = 0;
    if (grid == 0) {
        if (n_in != 18 || in_sizes[0] != M * D || out_size != M * D || ws_size < WS_END) { fprintf(stderr, "kernel_launch: unexpected shapes (n_in %d, in0 %d, out %d, ws %zu); nothing launched\n", n_in, n_in > 0 ? in_sizes[0] : -1, out_size, ws_size); grid = -1; return; }
        int dev = 0, cus = 0, per_cu = 0;
        if (hipGetDevice(&dev) != hipSuccess || hipDeviceGetAttribute(&cus, hipDeviceAttributeMultiprocessorCount, dev) != hipSuccess) { grid = -1; return; }
        if (hipFuncSetAttribute((const void*)mk_fwd, hipFuncAttributeMaxDynamicSharedMemorySize, LDS_BYTES) != hipSuccess) { fprintf(stderr, "kernel_launch: hipFuncSetAttribute failed\n"); grid = -1; return; }
        if (hipOccupancyMaxActiveBlocksPerMultiprocessor(&per_cu, (const void*)mk_fwd, NWAVES * 64, LDS_BYTES) != hipSuccess || per_cu < 1) { fprintf(stderr, "kernel_launch: occupancy query says %d blocks per CU\n", per_cu); (void)hipGetLastError(); grid = -1; return; }
        grid = cus;
    }
    if (grid < 0) return;
    if (hipMemsetAsync((char*)d_ws + WS_CTL, 0, CTL_ZERO_BYTES, stream) != hipSuccess) return;
    Args a{};
    for (int i = 0; i < 18; ++i) a.in[i] = (const float*)d_in[i];
    a.out = (float*)d_out; a.ws = (unsigned char*)d_ws;
#if MK_PER_PHASE
    for (int p = 0; p < NPHASE; ++p) { a.ph_lo = p; a.ph_hi = p + 1; hipLaunchKernelGGL(mk_fwd, dim3(grid), dim3(NWAVES * 64), LDS_BYTES, stream, a); }
#else
    a.ph_lo = 0; a.ph_hi = NPHASE; hipLaunchKernelGGL(mk_fwd, dim3(grid), dim3(NWAVES * 64), LDS_BYTES, stream, a);
#endif
}
```
